# Optimizing an MI355X kernel written in HIP

```python
import math
import jax, jax.numpy as jnp
from jax import lax
import numpy as np

D_MODEL = 1024
BATCH = 2
SEQ = 8192
DEPTH = 4

N_MIXERS = 3
D_FF = 2816
LN_EPS = 1e-5
DEEPNORM_ALPHA = (2 * DEPTH) ** 0.25
DEEPNORM_BETA = (8 * DEPTH) ** -0.25
MACARON_WEIGHT = 0.5

SSM_EXPAND = 2
SSM_D_INNER = SSM_EXPAND * D_MODEL
SSM_HEAD_DIM = 64
SSM_HEADS = SSM_D_INNER // SSM_HEAD_DIM
SSM_GROUPS = 4
SSM_HEADS_PER_GROUP = SSM_HEADS // SSM_GROUPS
SSM_D_STATE = 128
SSM_CONV = 4
SSM_CHUNK = 256
SSM_CONV_DIM = SSM_D_INNER + 2 * SSM_GROUPS * SSM_D_STATE
SSM_IN_DIM = 2 * SSM_D_INNER + 2 * SSM_GROUPS * SSM_D_STATE + SSM_HEADS

ATT_HEAD_DIM = 64
FOX_HEADS = D_MODEL // ATT_HEAD_DIM
FOX_Q_BLOCK = 128
MOBA_HEADS = D_MODEL // ATT_HEAD_DIM
MOBA_BLOCK = 256
MOBA_TOPK = 3
MOBA_Q_BLOCK = 32

N_SSM_LAYERS = (DEPTH + 2) // 3
N_FOX_LAYERS = (DEPTH + 1) // 3
N_MOBA_LAYERS = DEPTH // 3

kernel_name = 'hybrid_ssd_fox_moba_macaron_deepnorm'


def layer_norm(x, g, b):
    xf = x.astype(jnp.float32)
    mu = jnp.mean(xf, -1, keepdims=True)
    var = jnp.mean(jnp.square(xf - mu), -1, keepdims=True)
    return ((xf - mu) * lax.rsqrt(var + LN_EPS) * g + b).astype(x.dtype)


def swiglu(x, w_gate, w_up, w_down):
    return (jax.nn.silu(x @ w_gate) * (x @ w_up)) @ w_down


def segsum(a):
    T = a.shape[-1]
    cs = jnp.cumsum(a, axis=-1)
    diff = cs[..., :, None] - cs[..., None, :]
    return jnp.where(jnp.tril(jnp.ones((T, T), dtype=bool)), diff, -jnp.inf)


def ssd_chunked(xdt, adt, b, c):
    Bsz, S, G, R, P = xdt.shape
    N = b.shape[-1]
    Q = SSM_CHUNK
    nc = -(-S // Q)
    pad = nc * Q - S
    padseq = lambda t: jnp.pad(t, [(0, 0), (0, pad)] + [(0, 0)] * (t.ndim - 2))
    xdt, adt, b, c = padseq(xdt), padseq(adt), padseq(b), padseq(c)
    xdt = xdt.reshape(Bsz, nc, Q, G, R, P)
    b = b.reshape(Bsz, nc, Q, G, N)
    c = c.reshape(Bsz, nc, Q, G, N)
    a_t = adt.reshape(Bsz, nc, Q, G, R).transpose(0, 1, 3, 4, 2)
    a_cs = jnp.cumsum(a_t, axis=-1)
    decay_in = jnp.exp(segsum(a_t))
    cb = jnp.einsum('bclgn,bcsgn->bcgls', c, b)
    m = cb[:, :, :, None] * decay_in
    y_diag = jnp.einsum('bcgrls,bcsgrp->bclgrp', m, xdt)
    decay_to_end = jnp.exp(a_cs[..., -1:] - a_cs).transpose(0, 1, 4, 2, 3)
    states = jnp.einsum('bcsgn,bcsgrp->bcgrpn', b, xdt * decay_to_end[..., None])
    states = jnp.concatenate([jnp.zeros_like(states[:, :1]), states], axis=1)
    a_last = jnp.pad(a_cs[..., -1].transpose(0, 2, 3, 1), [(0, 0), (0, 0), (0, 0), (1, 0)])
    chunk_decay = jnp.exp(segsum(a_last))
    states = jnp.einsum('bgrzc,bcgrpn->bzgrpn', chunk_decay, states)[:, :-1]
    decay_out = jnp.exp(a_cs).transpose(0, 1, 4, 2, 3)
    y_off = jnp.einsum('bclgn,bcgrpn->bclgrp', c, states) * decay_out[..., None]
    return (y_diag + y_off).reshape(Bsz, nc * Q, G, R, P)[:, :S]


def mamba2_mixer(x, w_in, conv_w, conv_b, dt_bias, a_log, d_skip, norm_w, w_out):
    Bsz, S, _ = x.shape
    G, R, P, N = SSM_GROUPS, SSM_HEADS_PER_GROUP, SSM_HEAD_DIM, SSM_D_STATE
    f32 = jnp.float32
    zxbcdt = x @ w_in
    z, xbc, dt = jnp.split(zxbcdt, [SSM_D_INNER, SSM_D_INNER + SSM_CONV_DIM], axis=-1)
    xbc = lax.conv_general_dilated(
        xbc, conv_w[:, None, :], window_strides=(1,), padding=[(SSM_CONV - 1, 0)],
        dimension_numbers=('NWC', 'WIO', 'NWC'), feature_group_count=SSM_CONV_DIM) + conv_b
    xbc = jax.nn.silu(xbc)
    xs, b_ssm, c_ssm = jnp.split(xbc, [SSM_D_INNER, SSM_D_INNER + G * N], axis=-1)
    dt = jax.nn.softplus(dt.astype(f32) + dt_bias.astype(f32))
    a = -jnp.exp(a_log.astype(f32))
    xh = xs.astype(f32).reshape(Bsz, S, G, R, P)
    bg = b_ssm.astype(f32).reshape(Bsz, S, G, N)
    cg = c_ssm.astype(f32).reshape(Bsz, S, G, N)
    y = ssd_chunked(xh * dt.reshape(Bsz, S, G, R)[..., None], (dt * a).reshape(Bsz, S, G, R), bg, cg)
    y = y + xh * d_skip.astype(f32).reshape(G, R)[:, :, None]
    y = y.reshape(Bsz, S, SSM_D_INNER) * jax.nn.silu(z.astype(f32))
    yg = y.reshape(Bsz, S, G, SSM_D_INNER // G)
    yg = yg * lax.rsqrt(jnp.mean(jnp.square(yg), -1, keepdims=True) + LN_EPS)
    y = yg.reshape(Bsz, S, SSM_D_INNER) * norm_w
    return y.astype(x.dtype) @ w_out


def fox_attention(x, w_in, b_f, w_out):
    Bsz, S, _ = x.shape
    H, Dh, QB = FOX_HEADS, ATT_HEAD_DIM, FOX_Q_BLOCK
    f32 = jnp.float32
    proj = x @ w_in
    q, k, v, f_logit = jnp.split(proj, [H * Dh, 2 * H * Dh, 3 * H * Dh], axis=-1)
    to_heads = lambda t: t.reshape(Bsz, S, H, Dh).transpose(0, 2, 1, 3).astype(f32)
    q, k, v = to_heads(q), to_heads(k), to_heads(v)
    log_f = jax.nn.log_sigmoid(f_logit.astype(f32) + b_f.astype(f32))
    cum = jnp.cumsum(log_f, axis=1).transpose(0, 2, 1)
    scale = Dh ** -0.5
    kpos = jnp.arange(S)

    def block(i):
        start = i * QB
        qb = lax.dynamic_slice_in_dim(q, start, QB, axis=2)
        cq = lax.dynamic_slice_in_dim(cum, start, QB, axis=2)
        logits = jnp.einsum('bhqd,bhkd->bhqk', qb, k) * scale + (cq[..., :, None] - cum[..., None, :])
        qpos = start + jnp.arange(QB)
        logits = jnp.where(kpos[None, :] <= qpos[:, None], logits, -jnp.inf)
        p = jax.nn.softmax(logits, axis=-1)
        return jnp.einsum('bhqk,bhkd->bhqd', p, v)

    o = lax.map(block, jnp.arange(S // QB))
    o = o.transpose(1, 0, 3, 2, 4).reshape(Bsz, S, H * Dh)
    return o.astype(x.dtype) @ w_out


def moba_attention(x, w_in, w_out):
    Bsz, S, _ = x.shape
    H, Dh, L, QB = MOBA_HEADS, ATT_HEAD_DIM, MOBA_BLOCK, MOBA_Q_BLOCK
    f32 = jnp.float32
    proj = x @ w_in
    q, k, v = jnp.split(proj, [H * Dh, 2 * H * Dh], axis=-1)
    to_heads = lambda t: t.reshape(Bsz, S, H, Dh).transpose(0, 2, 1, 3).astype(f32)
    q, k, v = to_heads(q), to_heads(k), to_heads(v)
    nb = -(-S // L)
    pad = nb * L - S
    k_blk = jnp.pad(k, [(0, 0), (0, 0), (0, pad), (0, 0)]).reshape(Bsz, H, nb, L, Dh)
    v_blk = jnp.pad(v, [(0, 0), (0, 0), (0, pad), (0, 0)]).reshape(Bsz, H, nb, L, Dh)
    k_mean = jnp.mean(k_blk, axis=3)
    k_sel_n = min(MOBA_TOPK, nb)
    scale = Dh ** -0.5
    bi = jnp.arange(Bsz)[:, None, None, None]
    hi = jnp.arange(H)[None, :, None, None]
    blk_ids = jnp.arange(nb)

    def chunk(i):
        start = i * QB
        own = start // L
        qc = lax.dynamic_slice_in_dim(q, start, QB, axis=2)
        gate = jnp.einsum('bhqd,bhnd->bhqn', qc, k_mean)
        gate = jnp.where(blk_ids < own, gate, -jnp.inf)
        _, idx = lax.top_k(gate, k_sel_n)
        valid = jnp.arange(k_sel_n) < own
        k_sel = k_blk[bi, hi, idx]
        v_sel = v_blk[bi, hi, idx]
        s_past = jnp.einsum('bhqd,bhqnld->bhqnl', qc, k_sel) * scale
        s_past = jnp.where(valid[:, None], s_past, -jnp.inf).reshape(Bsz, H, QB, k_sel_n * L)
        k_own = lax.dynamic_index_in_dim(k_blk, own, axis=2, keepdims=False)
        v_own = lax.dynamic_index_in_dim(v_blk, own, axis=2, keepdims=False)
        s_own = jnp.einsum('bhqd,bhld->bhql', qc, k_own) * scale
        qpos = start + jnp.arange(QB)
        kpos = own * L + jnp.arange(L)
        s_own = jnp.where(kpos[None, :] <= qpos[:, None], s_own, -jnp.inf)
        p = jax.nn.softmax(jnp.concatenate([s_past, s_own], axis=-1), axis=-1)
        o = jnp.einsum('bhqm,bhqmd->bhqd', p[..., :k_sel_n * L], v_sel.reshape(Bsz, H, QB, k_sel_n * L, Dh))
        return o + jnp.einsum('bhql,bhld->bhqd', p[..., k_sel_n * L:], v_own)

    o = lax.map(chunk, jnp.arange(S // QB))
    o = o.transpose(1, 0, 3, 2, 4).reshape(Bsz, S, H * Dh)
    return o.astype(x.dtype) @ w_out


def setup_inputs(seed: int = 0) -> dict:
    key = jax.random.key(seed)
    ks = jax.random.split(key, 20)
    f32 = jnp.float32
    nrm = lambda k, shape, s: jax.random.normal(k, shape, f32) * s
    x = nrm(ks[0], (BATCH, SEQ, D_MODEL), 1.0)
    ffn_w_gate = nrm(ks[1], (DEPTH, 2, D_MODEL, D_FF), D_MODEL ** -0.5)
    ffn_w_up = nrm(ks[2], (DEPTH, 2, D_MODEL, D_FF), D_MODEL ** -0.5)
    ffn_w_down = nrm(ks[3], (DEPTH, 2, D_FF, D_MODEL), D_FF ** -0.5 * DEEPNORM_BETA)
    ln_g = 1.0 + nrm(ks[4], (DEPTH, 3, D_MODEL), 0.02)
    ln_b = nrm(ks[5], (DEPTH, 3, D_MODEL), 0.02)
    ssm_w_in = nrm(ks[6], (N_SSM_LAYERS, D_MODEL, SSM_IN_DIM), D_MODEL ** -0.5)
    ssm_conv_w = nrm(ks[7], (N_SSM_LAYERS, SSM_CONV, SSM_CONV_DIM), SSM_CONV ** -0.5)
    ssm_conv_b = nrm(ks[8], (N_SSM_LAYERS, SSM_CONV_DIM), 0.02)
    dt0 = jnp.exp(jax.random.uniform(ks[9], (N_SSM_LAYERS, SSM_HEADS), f32, math.log(1e-3), math.log(1e-1)))
    ssm_dt_bias = dt0 + jnp.log(-jnp.expm1(-dt0))
    ssm_a_log = jnp.log(jax.random.uniform(ks[10], (N_SSM_LAYERS, SSM_HEADS), f32, 1.0, 16.0))
    ssm_d = 1.0 + nrm(ks[11], (N_SSM_LAYERS, SSM_HEADS), 0.1)
    ssm_norm_w = 1.0 + nrm(ks[12], (N_SSM_LAYERS, SSM_D_INNER), 0.02)
    ssm_w_out = nrm(ks[13], (N_SSM_LAYERS, SSM_D_INNER, D_MODEL), SSM_D_INNER ** -0.5 * DEEPNORM_BETA)
    fox_w_in = nrm(ks[14], (N_FOX_LAYERS, D_MODEL, 3 * FOX_HEADS * ATT_HEAD_DIM + FOX_HEADS), D_MODEL ** -0.5)
    fox_b_f = jax.random.uniform(ks[15], (N_FOX_LAYERS, FOX_HEADS), f32, 1.0, 6.0)
    fox_w_out = nrm(ks[16], (N_FOX_LAYERS, FOX_HEADS * ATT_HEAD_DIM, D_MODEL), (FOX_HEADS * ATT_HEAD_DIM) ** -0.5 * DEEPNORM_BETA)
    moba_w_in = nrm(ks[17], (N_MOBA_LAYERS, D_MODEL, 3 * MOBA_HEADS * ATT_HEAD_DIM), D_MODEL ** -0.5)
    moba_w_out = nrm(ks[18], (N_MOBA_LAYERS, MOBA_HEADS * ATT_HEAD_DIM, D_MODEL), (MOBA_HEADS * ATT_HEAD_DIM) ** -0.5 * DEEPNORM_BETA)
    return {'x': x, 'ffn_w_gate': ffn_w_gate, 'ffn_w_up': ffn_w_up, 'ffn_w_down': ffn_w_down,
            'ln_g': ln_g, 'ln_b': ln_b,
            'ssm_w_in': ssm_w_in, 'ssm_conv_w': ssm_conv_w, 'ssm_conv_b': ssm_conv_b,
            'ssm_dt_bias': ssm_dt_bias, 'ssm_a_log': ssm_a_log, 'ssm_d': ssm_d,
            'ssm_norm_w': ssm_norm_w, 'ssm_w_out': ssm_w_out,
            'fox_w_in': fox_w_in, 'fox_b_f': fox_b_f, 'fox_w_out': fox_w_out,
            'moba_w_in': moba_w_in, 'moba_w_out': moba_w_out}


def reference(x, ffn_w_gate, ffn_w_up, ffn_w_down, ln_g, ln_b,
              ssm_w_in, ssm_conv_w, ssm_conv_b, ssm_dt_bias, ssm_a_log, ssm_d, ssm_norm_w, ssm_w_out,
              fox_w_in, fox_b_f, fox_w_out, moba_w_in, moba_w_out):
    h = x
    for layer in range(DEPTH):
        kind, j = layer % N_MIXERS, layer // N_MIXERS
        ff = swiglu(h, ffn_w_gate[layer, 0], ffn_w_up[layer, 0], ffn_w_down[layer, 0])
        h = layer_norm(DEEPNORM_ALPHA * h + MACARON_WEIGHT * ff, ln_g[layer, 0], ln_b[layer, 0])
        if kind == 0:
            mix = mamba2_mixer(h, ssm_w_in[j], ssm_conv_w[j], ssm_conv_b[j], ssm_dt_bias[j],
                               ssm_a_log[j], ssm_d[j], ssm_norm_w[j], ssm_w_out[j])
        elif kind == 1:
            mix = fox_attention(h, fox_w_in[j], fox_b_f[j], fox_w_out[j])
        else:
            mix = moba_attention(h, moba_w_in[j], moba_w_out[j])
        h = layer_norm(DEEPNORM_ALPHA * h + mix, ln_g[layer, 1], ln_b[layer, 1])
        ff = swiglu(h, ffn_w_gate[layer, 1], ffn_w_up[layer, 1], ffn_w_down[layer, 1])
        h = layer_norm(DEEPNORM_ALPHA * h + MACARON_WEIGHT * ff, ln_g[layer, 2], ln_b[layer, 2])
    return h
```

```cpp
#include <hip/hip_runtime.h>
#include <hip/hip_cooperative_groups.h>
#include <cstdio>
#include <cstdint>
namespace cg = cooperative_groups;
#ifndef MK_MULTI
#define MK_MULTI 0
#endif
namespace pg8 {
#define PG8_LAS __attribute__((address_space(3)))
typedef unsigned short bf16_t;
typedef short bf16x8 __attribute__((ext_vector_type(8)));
typedef float f32x4 __attribute__((ext_vector_type(4)));
typedef unsigned u32x4 __attribute__((ext_vector_type(4)));
constexpr int BM = 256, BK = 64, HALF = 128, HTB = HALF * BK * 2  , STAGE_BYTES = 8 * HTB, NXCD = 8, WGM = 8;

__host__ __device__ __forceinline__ int lds_byte(int r, int c) { const int st = (r >> 4) * 2 + (c >> 5), rr = r & 15, cc = c & 31, ob = rr * 64 + cc * 2; return st * 1024 + (ob ^ (((ob >> 9) & 1) << 5)); }
__host__ __device__ __forceinline__ void stage_rc(int b, int& R, int& C) { const int st = b / 1024, sb = b % 1024, swz = sb ^ (((sb >> 9) & 1) << 5); R = (st >> 1) * 16 + swz / 64; C = (st & 1) * 32 + (swz % 64) / 2; }
__host__ __device__ __forceinline__ int perm32(int rho) { const int n = rho >> 4, i = rho & 15; return 8 * (i >> 2) + 4 * n + (i & 3); }

struct Unit { int pm, pn; };
struct Gemm { const bf16_t* A; const bf16_t* Bt; int M, N, K; };

struct StaticOrder {
    int nM, nN, nwg, G, c;
    __host__ __device__ void init(int M, int N, int G_, int c_) { nM = M / BM; nN = N / BM; nwg = nM * nN; G = G_; c = c_; }
    __host__ __device__ bool next(int i, Unit& u) const {
        const long L = (long)i * G + c; if (L >= nwg) return false;
        int wgid = (int)L; { const int q = nwg / NXCD, r = nwg % NXCD, xcd = wgid % NXCD, off = wgid / NXCD; wgid = (xcd < r ? xcd * (q + 1) : r * (q + 1) + (xcd - r) * q) + off; }
        const int nig = WGM * nN, gid = wgid / nig, fm = gid * WGM, gsz = (nM - fm) < WGM ? (nM - fm) : WGM;
        u.pm = fm + ((wgid % nig) % gsz); u.pn = (wgid % nig) / gsz; return true;
    }
    __device__ __forceinline__ void a_ready(const Unit&) const {}
    __device__ __forceinline__ void done(const Unit&) const {}
};
template <class Epi, class Sched, bool ALIGN_EPI = false, bool SP2 = false>
__device__ __forceinline__ void gemm_phase(PG8_LAS unsigned char* lds, const Gemm g, const Sched& S, const Epi& E) {
    const int tid = threadIdx.x, wid = __builtin_amdgcn_readfirstlane(tid >> 6), lane = tid & 63, wr = wid >> 2, wc = wid & 3, fr = lane & 15, fq = lane >> 4;
    const int K = g.K, nt = K / BK;
    unsigned voffA[2], voffB[2];
#pragma unroll
    for (int i = 0; i < 2; ++i) { int R, C; stage_rc(tid * 16 + i * 8192, R, C); const int Rb = Epi::PERM ? ((R & ~31) + perm32(R & 31)) : R;
        voffA[i] = (unsigned)(R * K + C) * 2u; voffB[i] = (unsigned)(Rb * K + C) * 2u; }
    const size_t kstep = (size_t)(BK * 2);
    const size_t hstep = (size_t)HALF * K * 2;
    const size_t tstep = 2 * hstep;
    const unsigned ldsw = (unsigned)wid * 1024u;
    const int aoff = lds_byte(wr * 64 + fr, fq * 8), boff = lds_byte(wc * 32 + fr, fq * 8);
#define PG8_SA(b, h) (((b) * 2 + (h)) * HTB)
#define PG8_SB(b, h) ((4 + (b) * 2 + (h)) * HTB)
#define PG8_STAGE(bufoff, gbase, voff) do { _Pragma("unroll") for (int _i = 0; _i < 2; ++_i) \
        __builtin_amdgcn_global_load_lds((const unsigned*)((const char*)(gbase) + (voff)[_i]), (PG8_LAS unsigned*)(lds + (bufoff) + ldsw + _i * 8192), 16, 0, 0); } while (0)
#define PG8_LDA(dst, b, h) do { _Pragma("unroll") for (int m = 0; m < 4; ++m) _Pragma("unroll") for (int k = 0; k < 2; ++k) dst[m][k] = *(const PG8_LAS bf16x8*)(lds + PG8_SA(b, h) + aoff + m * 2048 + k * 1024); } while (0)
#define PG8_LDB(dst, b, h) do { _Pragma("unroll") for (int n = 0; n < 2; ++n) _Pragma("unroll") for (int k = 0; k < 2; ++k) dst[n][k] = *(const PG8_LAS bf16x8*)(lds + PG8_SB(b, h) + boff + n * 2048 + k * 1024); } while (0)
#define PG8_MMA(ai, bj, At, Bt) do { __builtin_amdgcn_s_setprio(1); _Pragma("unroll") for (int m = 0; m < 4; ++m) _Pragma("unroll") for (int n = 0; n < 2; ++n) _Pragma("unroll") for (int k = 0; k < 2; ++k) \
        acc[ai][bj][m][n] = __builtin_amdgcn_mfma_f32_16x16x32_bf16(Bt[n][k], At[m][k], acc[ai][bj][m][n], 0, 0, 0); __builtin_amdgcn_s_setprio(0); } while (0)
#define PG8_WAIT_V(n) asm volatile("s_waitcnt vmcnt(" #n ")" ::: "memory")
#define PG8_WAIT_L(n) asm volatile("s_waitcnt lgkmcnt(" #n ")" ::: "memory")
#define PG8_BAR __builtin_amdgcn_s_barrier()
#define PG8_SCHED __builtin_amdgcn_sched_barrier(0)
    Unit cur, nxt; int ui = 0;
    if (!S.next(0, cur)) return;
    f32x4 acc[2][2][4][2];
#pragma unroll
    for (int a = 0; a < 2; ++a)
#pragma unroll
        for (int b = 0; b < 2; ++b)
#pragma unroll
            for (int m = 0; m < 4; ++m)
#pragma unroll
                for (int n = 0; n < 2; ++n) acc[a][b][m][n] = (f32x4){0.f, 0.f, 0.f, 0.f};
    bf16x8 At[4][2], B0[2][2], B1[2][2];
    const char* cA = (const char*)g.A + (size_t)cur.pm * tstep; const char* cB = (const char*)g.Bt + (size_t)cur.pn * tstep;
    S.a_ready(cur);
    if constexpr (SP2) {
        PG8_STAGE(PG8_SB(0, 0), cB, voffB); PG8_STAGE(PG8_SB(0, 1), cB + hstep, voffB); PG8_STAGE(PG8_SA(0, 0), cA, voffA); PG8_STAGE(PG8_SA(0, 1), cA + hstep, voffA);
        if (wr == 1) PG8_BAR;
        PG8_WAIT_V(2); PG8_BAR;
        PG8_STAGE(PG8_SB(1, 0), cB + kstep, voffB); PG8_STAGE(PG8_SA(1, 0), cA + kstep, voffA); PG8_STAGE(PG8_SB(1, 1), cB + hstep + kstep, voffB);
        PG8_WAIT_V(6); PG8_BAR;
    } else {
        PG8_STAGE(PG8_SB(0, 0), cB, voffB); PG8_STAGE(PG8_SA(0, 0), cA, voffA); PG8_STAGE(PG8_SB(0, 1), cB + hstep, voffB); PG8_STAGE(PG8_SA(0, 1), cA + hstep, voffA);
        if (wr == 1) PG8_BAR;
        PG8_WAIT_V(4); PG8_BAR;
        PG8_STAGE(PG8_SB(1, 0), cB + kstep, voffB); PG8_STAGE(PG8_SA(1, 0), cA + kstep, voffA); PG8_STAGE(PG8_SB(1, 1), cB + hstep + kstep, voffB);
        PG8_WAIT_V(6); PG8_BAR;
    }
    for (;;) {
        const bool has_next = S.next(ui + 1, nxt);
        const char* nA = has_next ? (const char*)g.A + (size_t)nxt.pm * tstep : cA; const char* nB = has_next ? (const char*)g.Bt + (size_t)nxt.pn * tstep : cB;
        for (int t = 0; t < nt; t += 2) {
            const bool last = (t == nt - 2);
            const char* a1 = cA + (size_t)(t + 1) * kstep;
            const char* a2 = last ? nA : cA + (size_t)(t + 2) * kstep; const char* b2 = last ? nB : cB + (size_t)(t + 2) * kstep;
            const char* a3 = a2 + kstep; const char* b3 = b2 + kstep;
            if (last && has_next) S.a_ready(nxt);
            if constexpr (SP2) {
            PG8_LDB(B0, 0, 0); PG8_LDB(B1, 0, 1); PG8_SCHED; PG8_LDA(At, 0, 0); PG8_STAGE(PG8_SA(1, 1), a1 + hstep, voffA);
            PG8_WAIT_V(8); PG8_WAIT_L(0); PG8_BAR; PG8_MMA(0, 0, At, B0); PG8_MMA(0, 1, At, B1); PG8_BAR; PG8_SCHED;
            PG8_LDA(At, 0, 1); PG8_STAGE(PG8_SB(0, 0), b2, voffB); PG8_STAGE(PG8_SB(0, 1), b2 + hstep, voffB); PG8_STAGE(PG8_SA(0, 0), a2, voffA);
            PG8_WAIT_V(8); PG8_WAIT_L(0); PG8_BAR; PG8_MMA(1, 0, At, B0); PG8_MMA(1, 1, At, B1); PG8_BAR; PG8_SCHED;
            PG8_LDB(B0, 1, 0); PG8_LDB(B1, 1, 1); PG8_SCHED; PG8_LDA(At, 1, 0); PG8_STAGE(PG8_SA(0, 1), a2 + hstep, voffA);
            PG8_WAIT_V(8); PG8_WAIT_L(0); PG8_BAR; PG8_MMA(0, 0, At, B0); PG8_MMA(0, 1, At, B1); PG8_BAR; PG8_SCHED;
            PG8_LDA(At, 1, 1); PG8_STAGE(PG8_SB(1, 0), b3, voffB); PG8_STAGE(PG8_SB(1, 1), b3 + hstep, voffB); PG8_STAGE(PG8_SA(1, 0), a3, voffA);
            PG8_WAIT_V(8); PG8_WAIT_L(0); PG8_BAR; PG8_MMA(1, 0, At, B0); PG8_MMA(1, 1, At, B1); PG8_BAR; PG8_SCHED;
            } else {
            PG8_LDB(B0, 0, 0); PG8_SCHED; PG8_LDA(At, 0, 0); PG8_STAGE(PG8_SA(1, 1), a1 + hstep, voffA);
            PG8_WAIT_L(8); PG8_BAR; PG8_WAIT_L(0); PG8_MMA(0, 0, At, B0); PG8_BAR; PG8_SCHED;
            PG8_LDB(B1, 0, 1); PG8_STAGE(PG8_SB(0, 0), b2, voffB);
            PG8_BAR; PG8_WAIT_L(0); PG8_MMA(0, 1, At, B1); PG8_BAR;
            PG8_LDA(At, 0, 1); PG8_STAGE(PG8_SA(0, 0), a2, voffA);
            PG8_BAR; PG8_WAIT_L(0); PG8_MMA(1, 0, At, B0); PG8_BAR; PG8_SCHED;
            PG8_STAGE(PG8_SB(0, 1), b2 + hstep, voffB);
            PG8_WAIT_V(6); PG8_BAR; PG8_MMA(1, 1, At, B1); PG8_BAR;
            PG8_LDB(B0, 1, 0); PG8_SCHED; PG8_LDA(At, 1, 0); PG8_STAGE(PG8_SA(0, 1), a2 + hstep, voffA);
            PG8_WAIT_L(8); PG8_BAR; PG8_WAIT_L(0); PG8_MMA(0, 0, At, B0); PG8_BAR; PG8_SCHED;
            PG8_LDB(B1, 1, 1); PG8_STAGE(PG8_SB(1, 0), b3, voffB);
            PG8_BAR; PG8_WAIT_L(0); PG8_MMA(0, 1, At, B1); PG8_BAR;
            PG8_LDA(At, 1, 1); PG8_STAGE(PG8_SA(1, 0), a3, voffA);
            PG8_BAR; PG8_WAIT_L(0); PG8_MMA(1, 0, At, B0); PG8_BAR; PG8_SCHED;
            PG8_STAGE(PG8_SB(1, 1), b3 + hstep, voffB);
            PG8_WAIT_V(6); PG8_BAR; PG8_MMA(1, 1, At, B1); PG8_BAR;
            }
        }
        if constexpr (ALIGN_EPI) { if (wr == 0) PG8_BAR; }
        if constexpr (!Epi::AFTER_DRAIN) { E(acc, cur, wr, wc, fr, fq); S.done(cur); }
        if (!has_next) break;
#pragma unroll
        for (int a = 0; a < 2; ++a)
#pragma unroll
            for (int b = 0; b < 2; ++b)
#pragma unroll
                for (int m = 0; m < 4; ++m)
#pragma unroll
                    for (int n = 0; n < 2; ++n) acc[a][b][m][n] = (f32x4){0.f, 0.f, 0.f, 0.f};
        cur = nxt; cA = nA; cB = nB; ++ui;
        if constexpr (ALIGN_EPI) { if (wr == 1) PG8_BAR; }
    }
    PG8_WAIT_V(0);
    if constexpr (!ALIGN_EPI) { if (wr == 0) PG8_BAR; }
    PG8_BAR;
    if constexpr (Epi::AFTER_DRAIN) { E.fused(acc, cur, wr, wc, fr, fq, lds, wid, lane); S.done(cur); }
#undef PG8_SA
#undef PG8_SB
#undef PG8_STAGE
#undef PG8_LDA
#undef PG8_LDB
#undef PG8_MMA
#undef PG8_WAIT_V
#undef PG8_WAIT_L
#undef PG8_BAR
#undef PG8_SCHED
}
}

#define LAS __attribute__((address_space(3)))
typedef unsigned short bf16;
typedef float f32x4 __attribute__((ext_vector_type(4)));
typedef float f32x16 __attribute__((ext_vector_type(16)));
typedef short bf16x8 __attribute__((ext_vector_type(8)));
typedef unsigned u32x4 __attribute__((ext_vector_type(4)));
typedef unsigned u32x2 __attribute__((ext_vector_type(2)));
typedef float f32x2_t __attribute__((ext_vector_type(2)));
typedef __bf16 bf16x2_t __attribute__((ext_vector_type(2)));

constexpr int SEQ = 8192, MTOK = 16384, DM = 1024, DFF = 2816;
constexpr float ALPHA = 1.6817928305074290f;
constexpr float LOG2E = 1.4426950408889634f;
constexpr float QSCALE = 0.125f * LOG2E;
constexpr float LN_EPS = 1e-5f;
constexpr size_t MiB = 1u << 20;
constexpr size_t WS_WGU0 = 0, WS_WD0 = 11 * MiB, WS_WGU1 = 33 * MiB / 2, WS_WD1 = 55 * MiB / 2, WS_WIN = 33 * MiB, WS_WOUT = 87 * MiB / 2;
constexpr size_t WS_H16 = 48 * MiB, WS_BM = 48 * MiB, WS_CM = 64 * MiB;
constexpr size_t WS_Z = 80 * MiB, WS_Q = 80 * MiB, WS_K = 112 * MiB, WS_ACT = 80 * MiB;
constexpr size_t WS_XBC = 144 * MiB, WS_ST = 144 * MiB, WS_SIN = 208 * MiB, WS_VT = 144 * MiB, WS_O = 176 * MiB;
constexpr size_t WS_XT = 240 * MiB, WS_Y = 240 * MiB, WS_BT = 304 * MiB, WS_YD = 320 * MiB;
constexpr size_t WS_DT = 384 * MiB, WS_ACS = 386 * MiB, WS_LF = 388 * MiB, WS_CUM = 389 * MiB, WS_KM = 390 * MiB, WS_END = 392 * MiB;
constexpr int LDS_BYTES = 147456;

__device__ __forceinline__ unsigned pk2(float lo, float hi) { f32x2_t v = {lo, hi}; bf16x2_t b = __builtin_convertvector(v, bf16x2_t); return __builtin_bit_cast(unsigned, b); }
__device__ __forceinline__ float bflo(unsigned x) { return __uint_as_float(x << 16); }
__device__ __forceinline__ float bfhi(unsigned x) { return __uint_as_float(x & 0xffff0000u); }
__device__ __forceinline__ float siluf(float v) { return v / (1.f + __expf(-v)); }
__device__ __forceinline__ int crow(int r, int hi) { return (r & 3) + 8 * (r >> 2) + 4 * hi; }
__device__ __forceinline__ float wave_sum(float v) {
#pragma unroll
    for (int o = 1; o < 64; o <<= 1) v += __shfl_xor(v, o);
    return v;
}

struct Args {
    const float *x, *wg, *wu, *wd, *lng, *lnb, *ssm_win, *ssm_cw, *ssm_cb, *ssm_dtb, *ssm_alog, *ssm_d, *ssm_nw, *ssm_wout,
        *fox_win, *fox_bf, *fox_wout, *moba_win, *moba_wout;
    float* out; unsigned char* ws; int ph_lo, ph_hi;
};

struct Epi {
    static constexpr bool PERM = false, AFTER_DRAIN = false;
    int mode; float w;
    float* out; unsigned char* ws; const float* bias;
    __device__ __forceinline__ void operator()(const pg8::f32x4 (&acc)[2][2][4][2], const pg8::Unit& u, int wr, int wc, int fr, int fq) const {
        const int row0 = u.pm * 256 + wr * 64 + fr;
        const int bb = u.pm >> 5;
        if (mode == 0) {
            const int colh = u.pn * 128 + wc * 32 + 4 * fq;
#pragma unroll
            for (int ai = 0; ai < 2; ++ai)
#pragma unroll
                for (int m = 0; m < 4; ++m) {
                    bf16* rp = (bf16*)(ws + WS_ACT) + (size_t)(row0 + ai * 128 + m * 16) * DFF + colh;
#pragma unroll
                    for (int n = 0; n < 2; ++n) {
                        const f32x4 g = acc[ai][0][m][n], uu = acc[ai][1][m][n];
                        u32x2 v; v.x = pk2(siluf(g[0]) * uu[0], siluf(g[1]) * uu[1]); v.y = pk2(siluf(g[2]) * uu[2], siluf(g[3]) * uu[3]);
                        *(u32x2*)(rp + 16 * n) = v;
                    }
                    asm volatile("" ::: "memory");
                }
        } else if (mode == 1) {
            const int col0 = u.pn * 256 + wc * 32 + 4 * fq;
#pragma unroll
            for (int ai = 0; ai < 2; ++ai)
#pragma unroll
                for (int m = 0; m < 4; ++m) {
                    float* rp = out + (size_t)(row0 + ai * 128 + m * 16) * DM + col0;
#pragma unroll
                    for (int bj = 0; bj < 2; ++bj)
#pragma unroll
                        for (int n = 0; n < 2; ++n) {
                            f32x4* p = (f32x4*)(rp + bj * 128 + 16 * n);
                            const f32x4 v = *p; *p = v * ALPHA + acc[ai][bj][m][n] * w;
                        }
                    asm volatile("" ::: "memory");
                }
        } else if (mode == 2) {
            if (u.pn < 20) {
                bf16* base; int ld, colt;
                if (u.pn < 8) { base = (bf16*)(ws + WS_Z); ld = 2048; colt = u.pn * 256; } else { base = (bf16*)(ws + WS_XBC); ld = 3072; colt = (u.pn - 8) * 256; }
                const int col0 = colt + wc * 32 + 4 * fq;
#pragma unroll
                for (int ai = 0; ai < 2; ++ai)
#pragma unroll
                    for (int m = 0; m < 4; ++m) {
                        bf16* rp = base + (size_t)(row0 + ai * 128 + m * 16) * ld + col0;
#pragma unroll
                        for (int bj = 0; bj < 2; ++bj)
#pragma unroll
                            for (int n = 0; n < 2; ++n) {
                                const f32x4 a = acc[ai][bj][m][n]; u32x2 v; v.x = pk2(a[0], a[1]); v.y = pk2(a[2], a[3]);
                                *(u32x2*)(rp + bj * 128 + 16 * n) = v;
                            }
                        asm volatile("" ::: "memory");
                    }
            } else if (wc == 0) {
#pragma unroll
                for (int n = 0; n < 2; ++n) {
                    const int hd = 16 * n + 4 * fq;
#pragma unroll
                    for (int j = 0; j < 4; ++j) {
                        const float bsv = bias[hd + j];
                        float* dp = (float*)(ws + WS_DT) + (size_t)(bb * 32 + hd + j) * SEQ;
#pragma unroll
                        for (int ai = 0; ai < 2; ++ai)
#pragma unroll
                            for (int m = 0; m < 4; ++m) {
                                const int s = (row0 + ai * 128 + m * 16) & (SEQ - 1);
                                const float xv = acc[ai][0][m][n][j] + bsv;
                                dp[s] = xv > 20.f ? xv : log1pf(__expf(xv));
                            }
                    }
                }
            }
        } else {
            if (u.pn < 8) {
                bf16* base = (bf16*)(ws + (u.pn < 4 ? WS_Q : WS_K)); const float sc = u.pn < 4 ? QSCALE : 1.f;
                const int col0 = (u.pn & 3) * 256 + wc * 32 + 4 * fq;
#pragma unroll
                for (int ai = 0; ai < 2; ++ai)
#pragma unroll
                    for (int m = 0; m < 4; ++m) {
                        bf16* rp = base + (size_t)(row0 + ai * 128 + m * 16) * DM + col0;
#pragma unroll
                        for (int bj = 0; bj < 2; ++bj)
#pragma unroll
                            for (int n = 0; n < 2; ++n) {
                                const f32x4 a = acc[ai][bj][m][n] * sc; u32x2 v; v.x = pk2(a[0], a[1]); v.y = pk2(a[2], a[3]);
                                *(u32x2*)(rp + bj * 128 + 16 * n) = v;
                            }
                        asm volatile("" ::: "memory");
                    }
            } else if (u.pn < 12) {
#pragma unroll
                for (int bj = 0; bj < 2; ++bj)
#pragma unroll
                    for (int n = 0; n < 2; ++n) {
                        const int c = (u.pn - 8) * 256 + bj * 128 + wc * 32 + 16 * n + 4 * fq;
#pragma unroll
                        for (int j = 0; j < 4; ++j) {
                            bf16* vp = (bf16*)(ws + WS_VT) + (size_t)((bb * 16 + ((c + j) >> 6)) * 64 + ((c + j) & 63)) * SEQ;
#pragma unroll
                            for (int ai = 0; ai < 2; ++ai)
#pragma unroll
                                for (int m = 0; m < 4; ++m) {
                                    const int s = (row0 + ai * 128 + m * 16) & (SEQ - 1);
                                    vp[s] = (bf16)(pk2(acc[ai][bj][m][n][j], 0.f) & 0xffffu);
                                }
                        }
                    }
            } else if (wc == 0 && fq < 4) {
#pragma unroll
                for (int j = 0; j < 4; ++j) {
                    const int hd = 4 * fq + j; const float bsv = bias[hd];
                    float* dp = (float*)(ws + WS_LF) + (size_t)(bb * 16 + hd) * SEQ;
#pragma unroll
                    for (int ai = 0; ai < 2; ++ai)
#pragma unroll
                        for (int m = 0; m < 4; ++m) {
                            const int s = (row0 + ai * 128 + m * 16) & (SEQ - 1);
                            const float xv = acc[ai][0][m][0][j] + bsv;
                            dp[s] = xv >= 0.f ? -log1pf(__expf(-xv)) : xv - log1pf(__expf(xv));
                        }
                }
            }
        }
    }
};

struct EpiRes {
    static constexpr bool PERM = false, AFTER_DRAIN = false;
    float w; float* out;
    __device__ __forceinline__ void operator()(const pg8::f32x4 (&acc)[2][2][4][2], const pg8::Unit& u, int wr, int wc, int fr, int fq) const {
        const int row0 = u.pm * 256 + wr * 64 + fr, col0 = u.pn * 256 + wc * 32 + 4 * fq;
#pragma unroll
        for (int ai = 0; ai < 2; ++ai)
#pragma unroll
            for (int m = 0; m < 4; ++m) {
                float* rp = out + (size_t)(row0 + ai * 128 + m * 16) * DM + col0;
#pragma unroll
                for (int bj = 0; bj < 2; ++bj)
#pragma unroll
                    for (int n = 0; n < 2; ++n) { f32x4* p = (f32x4*)(rp + bj * 128 + 16 * n); const f32x4 v = *p; *p = v * ALPHA + acc[ai][bj][m][n] * w; }
                asm volatile("" ::: "memory");
            }
    }
};
__device__ __forceinline__ void tr_item(const float* W, int K, int N, bf16* WT, int dst_row0, const float* kscale, LAS float* scr, int k0, int n0, int lane) {
    const int nn = n0 + (lane & 31);
#pragma unroll 8
    for (int i = 0; i < 32; ++i) {
        const int kk = 2 * i + (lane >> 5);
        float v = nn < N ? W[(size_t)(k0 + kk) * N + nn] : 0.f;
        if (kscale) v *= kscale[k0 + kk];
        scr[kk * 33 + (lane & 31)] = v;
    }
    asm volatile("s_waitcnt lgkmcnt(0)" ::: "memory");
    const int c = lane & 7;
#pragma unroll
    for (int j = 0; j < 4; ++j) {
        const int n = (lane >> 3) + 8 * j; const LAS float* s = scr + (8 * c) * 33 + n;
        u32x4 o; o.x = pk2(s[0 * 33], s[1 * 33]); o.y = pk2(s[2 * 33], s[3 * 33]); o.z = pk2(s[4 * 33], s[5 * 33]); o.w = pk2(s[6 * 33], s[7 * 33]);
        *(u32x4*)(WT + (size_t)(dst_row0 + n) * K + k0 + 8 * c) = o;
    }
    asm volatile("s_waitcnt lgkmcnt(0)" ::: "memory");
}
struct MatD { const float* W; int K, N; bf16* WT; int kind; const float* ks; };
__device__ __forceinline__ MatD get_mat(const Args& a, int L, int mi) {
    MatD d; d.ks = nullptr; d.kind = 0;
    const int kind = L % 3, j = L / 3;
    unsigned char* ws = a.ws; asm volatile("" : "+s"(ws));
    if (mi < 6) {
        const int h = mi / 3, t = mi % 3; const size_t lo = (size_t)(L * 2 + h) * DM * DFF;
        if (t == 0) { d.W = a.wg + lo; d.K = DM; d.N = DFF; d.WT = (bf16*)(ws + (h ? WS_WGU1 : WS_WGU0)); d.kind = 1; }
        else if (t == 1) { d.W = a.wu + lo; d.K = DM; d.N = DFF; d.WT = (bf16*)(ws + (h ? WS_WGU1 : WS_WGU0)); d.kind = 2; }
        else { d.W = a.wd + lo; d.K = DFF; d.N = DM; d.WT = (bf16*)(ws + (h ? WS_WD1 : WS_WD0)); }
    } else if (mi == 6) {
        d.K = DM; d.WT = (bf16*)(ws + WS_WIN);
        if (kind == 0) { d.W = a.ssm_win + (size_t)j * DM * 5152; d.N = 5152; }
        else if (kind == 1) { d.W = a.fox_win + (size_t)j * DM * 3088; d.N = 3088; }
        else { d.W = a.moba_win + (size_t)j * DM * 3072; d.N = 3072; }
    } else {
        d.N = DM; d.WT = (bf16*)(ws + WS_WOUT);
        if (kind == 0) { d.W = a.ssm_wout + (size_t)j * 2048 * DM; d.K = 2048; d.ks = a.ssm_nw + j * 2048; }
        else if (kind == 1) { d.W = a.fox_wout + (size_t)j * DM * DM; d.K = DM; }
        else { d.W = a.moba_wout + (size_t)j * DM * DM; d.K = DM; }
    }
    return d;
}
__device__ __forceinline__ void convert_layer(const Args& a, int L, LAS unsigned char* lds, int gw, int NGW, int wid, int lane) {
    LAS float* scr = (LAS float*)(lds + wid * 8448);
    for (int mi = 0; mi < 8; ++mi) {
        const MatD d = get_mat(a, L, mi);
        const int nnb = (d.N + 31) / 32, cnt = (d.K / 64) * nnb;
        for (int it = gw; it < cnt; it += NGW) {
            const int kb = it / nnb, nb = it % nnb, n0 = nb * 32;
            const int dr = d.kind == 0 ? n0 : ((n0 >> 7) * 256 + (n0 & 127) + (d.kind == 2 ? 128 : 0));
            tr_item(d.W, d.K, d.N, d.WT, dr, d.ks, scr, kb * 64, n0, lane);
        }
    }
}

__device__ __forceinline__ void ln_pass(float* out, bf16* h16, const float* g, const float* bta, int gw, int NGW, int lane) {
    for (int row = gw; row < MTOK; row += NGW) {
        f32x4* xr = (f32x4*)(out + (size_t)row * DM) + lane;
        f32x4 v[4]; float s = 0.f;
#pragma unroll
        for (int j = 0; j < 4; ++j) { v[j] = xr[64 * j]; s += (v[j][0] + v[j][1]) + (v[j][2] + v[j][3]); }
        const float mean = wave_sum(s) * (1.f / DM); float s2 = 0.f;
#pragma unroll
        for (int j = 0; j < 4; ++j) { v[j] = v[j] - mean; s2 += (v[j][0] * v[j][0] + v[j][1] * v[j][1]) + (v[j][2] * v[j][2] + v[j][3] * v[j][3]); }
        const float rstd = 1.f / sqrtf(wave_sum(s2) * (1.f / DM) + LN_EPS);
        u32x2* o8 = (u32x2*)(h16 + (size_t)row * DM) + lane;
#pragma unroll
        for (int j = 0; j < 4; ++j) {
            const f32x4 gg = *((const f32x4*)g + lane + 64 * j), bb = *((const f32x4*)bta + lane + 64 * j);
            const f32x4 y = v[j] * rstd * gg + bb;
            xr[64 * j] = y;
            u32x2 p; p.x = pk2(y[0], y[1]); p.y = pk2(y[2], y[3]); o8[64 * j] = p;
        }
    }
}

__device__ __forceinline__ void conv_phase(const Args& a, int jj, int bid, int G, int tid, int wid, int lane) {
    unsigned char* ws = a.ws; asm volatile("" : "+s"(ws));
    const bf16* XBC = (const bf16*)(ws + WS_XBC);
    bf16* XT = (bf16*)(ws + WS_XT); bf16* BM = (bf16*)(ws + WS_BM); bf16* CMm = (bf16*)(ws + WS_CM); bf16* BT = (bf16*)(ws + WS_BT);
    const float* cw = a.ssm_cw + (size_t)jj * 4 * 3072; const float* cb = a.ssm_cb + (size_t)jj * 3072;
    for (int u = bid; u < 1536; u += G) {
        const int slab = u % 6, tt = (u / 6) % 128, b = u / 768;
        const int cp = tid & 255, tg = tid >> 8, ch = slab * 512 + 2 * cp, t0 = tt * 64 + tg * 32;
        float w0[4], w1[4];
#pragma unroll
        for (int k = 0; k < 4; ++k) { w0[k] = cw[k * 3072 + ch]; w1[k] = cw[k * 3072 + ch + 1]; }
        const float b0 = cb[ch], b1 = cb[ch + 1];
        const unsigned* src = (const unsigned*)(XBC + (size_t)(b * SEQ) * 3072 + ch);
        float xa[3], xb[3];
#pragma unroll
        for (int k = 0; k < 3; ++k) { const int t = t0 - 3 + k; unsigned v = 0u; if (t >= 0) v = src[(size_t)t * 1536]; xa[k] = bflo(v); xb[k] = bfhi(v); }
#pragma unroll
        for (int i8 = 0; i8 < 4; ++i8) {
            unsigned oa[4], ob[4];
#pragma unroll
            for (int i = 0; i < 8; ++i) {
                const int t = t0 + i8 * 8 + i;
                const unsigned v = src[(size_t)t * 1536];
                const float ca = bflo(v), cbv = bfhi(v);
                float ya = b0 + w0[0] * xa[0] + w0[1] * xa[1] + w0[2] * xa[2] + w0[3] * ca;
                float yb = b1 + w1[0] * xb[0] + w1[1] * xb[1] + w1[2] * xb[2] + w1[3] * cbv;
                xa[0] = xa[1]; xa[1] = xa[2]; xa[2] = ca; xb[0] = xb[1]; xb[1] = xb[2]; xb[2] = cbv;
                ya = siluf(ya); yb = siluf(yb);
                const unsigned pr = pk2(ya, yb);
                if (slab == 4) *(unsigned*)(BM + (size_t)(b * SEQ + t) * 512 + (ch - 2048)) = pr;
                if (slab == 5) *(unsigned*)(CMm + (size_t)(b * SEQ + t) * 512 + (ch - 2560)) = pr;
                if (i & 1) { oa[i >> 1] = (oa[i >> 1] & 0xffffu) | (pr << 16); ob[i >> 1] = (ob[i >> 1] & 0xffffu) | (pr & 0xffff0000u); }
                else { oa[i >> 1] = pr & 0xffffu; ob[i >> 1] = pr >> 16; }
            }
            const int ts = t0 + i8 * 8;
            if (slab < 4) {
                bf16* d = XT + (size_t)ch * SEQ + (size_t)b * 2048 * SEQ + ts;
                *(u32x4*)d = (u32x4){oa[0], oa[1], oa[2], oa[3]};
                *(u32x4*)(d + SEQ) = (u32x4){ob[0], ob[1], ob[2], ob[3]};
            } else if (slab == 4) {
                bf16* d = BT + (size_t)(b * 512 + (ch - 2048)) * SEQ + ts;
                *(u32x4*)d = (u32x4){oa[0], oa[1], oa[2], oa[3]};
                *(u32x4*)(d + SEQ) = (u32x4){ob[0], ob[1], ob[2], ob[3]};
            }
        }
    }
    const float* DT = (const float*)(ws + WS_DT); float* ACS = (float*)(ws + WS_ACS);
    for (int seg = bid * 8 + wid; seg < 2048; seg += G * 8) {
        const int b = seg >> 10, h = (seg >> 5) & 31, c = seg & 31;
        const float A = -__expf(a.ssm_alog[jj * 32 + h]);
        const size_t off = (size_t)(b * 32 + h) * SEQ + c * 256 + 4 * lane;
        f32x4 d = *(const f32x4*)(DT + off);
        f32x4 p; p[0] = d[0] * A; p[1] = p[0] + d[1] * A; p[2] = p[1] + d[2] * A; p[3] = p[2] + d[3] * A;
        float tot = p[3];
#pragma unroll
        for (int o = 1; o < 64; o <<= 1) { const float t = __shfl_up(tot, o); if (lane >= o) tot += t; }
        const float ex = tot - p[3];
        *(f32x4*)(ACS + off) = p + ex;
    }
}

__device__ __forceinline__ void ssd_diag_phase(const Args& a, int jj, LAS unsigned char* lds, int bid, int G, int tid, int wid, int lane) {
    unsigned char* ws = a.ws; asm volatile("" : "+s"(ws));
    const bf16* BM = (const bf16*)(ws + WS_BM); const bf16* CMm = (const bf16*)(ws + WS_CM); const bf16* XT = (const bf16*)(ws + WS_XT); const bf16* BT = (const bf16*)(ws + WS_BT);
    const float* DT = (const float*)(ws + WS_DT); const float* ACS = (const float*)(ws + WS_ACS);
    float* ST = (float*)(ws + WS_ST); unsigned* YD = (unsigned*)(ws + WS_YD);
    constexpr int L_BM = 0, L_XT = 69632, L_ACS = 103424, L_DT = 104448, L_WG = 105472;
    const int r32 = lane & 31, hi = lane >> 5;
    for (int u = bid; u < 2048; u += G) {
        const int b = u >> 10, c = (u >> 5) & 31, h = u & 31, g = h >> 3;
        __syncthreads();
#pragma unroll
        for (int k = 0; k < 8; ++k) {
            const int idx = tid + 512 * k, row = idx >> 4, pc = idx & 15;
            const u32x4 v = *(const u32x4*)(BM + (size_t)(b * SEQ + c * 256 + row) * 512 + g * 128 + pc * 8);
            *(LAS u32x4*)(lds + L_BM + row * 272 + pc * 16) = v;
        }
#pragma unroll
        for (int k = 0; k < 4; ++k) {
            const int idx = tid + 512 * k, row = idx >> 5, pc = idx & 31;
            const u32x4 v = *(const u32x4*)(XT + (size_t)((b * 32 + h) * 64 + row) * SEQ + c * 256 + pc * 8);
            *(LAS u32x4*)(lds + L_XT + row * 528 + pc * 16) = v;
        }
        if (tid < 256) {
            const size_t o = (size_t)(b * 32 + h) * SEQ + c * 256;
            const float ac = ACS[o + tid], dtv = DT[o + tid], al = ACS[o + 255];
            *(LAS float*)(lds + L_ACS + tid * 4) = ac * LOG2E;
            *(LAS float*)(lds + L_DT + tid * 4) = dtv;
            *(LAS float*)(lds + L_WG + tid * 4) = dtv * __expf(al - ac);
        }
        __syncthreads();
        const float Dh = a.ssm_d[jj * 32 + h];
        const int l = 32 * wid + r32;
        bf16x8 cf[8];
#pragma unroll
        for (int ks = 0; ks < 8; ++ks) cf[ks] = *(const bf16x8*)(CMm + (size_t)(b * SEQ + c * 256 + l) * 512 + g * 128 + 16 * ks + 8 * hi);
        const float acl = *(LAS float*)(lds + L_ACS + l * 4);
        f32x16 o[2]; o[0] = f32x16{}; o[1] = f32x16{};
        for (int j = 0; j <= wid; ++j) {
            f32x16 gt = f32x16{};
#pragma unroll
            for (int ks = 0; ks < 8; ++ks) {
                const bf16x8 bfr = *(LAS bf16x8*)(lds + L_BM + (32 * j + r32) * 272 + (16 * ks + 8 * hi) * 2);
                gt = __builtin_amdgcn_mfma_f32_32x32x16_bf16(bfr, cf[ks], gt, 0, 0, 0);
            }
            unsigned pw[8];
#pragma unroll
            for (int i = 0; i < 4; ++i) {
                const int sb = 32 * j + 8 * i + 4 * hi;
                const f32x4 a4 = *(LAS f32x4*)(lds + L_ACS + sb * 4), d4 = *(LAS f32x4*)(lds + L_DT + sb * 4);
                float pv[4];
#pragma unroll
                for (int q = 0; q < 4; ++q) {
                    float val = gt[4 * i + q] * __builtin_amdgcn_exp2f(acl - a4[q]) * d4[q];
                    if (j == wid) { const int s = sb + q; val = (s <= l) ? val : 0.f; if (s == l) val += Dh; }
                    pv[q] = val;
                }
                pw[2 * i] = pk2(pv[0], pv[1]); pw[2 * i + 1] = pk2(pv[2], pv[3]);
            }
#pragma unroll
            for (int ks = 0; ks < 2; ++ks) {
                const bf16x8 pf = __builtin_bit_cast(bf16x8, (u32x4){pw[4 * ks], pw[4 * ks + 1], pw[4 * ks + 2], pw[4 * ks + 3]});
#pragma unroll
                for (int d0 = 0; d0 < 2; ++d0) {
                    const LAS unsigned char* xp = lds + L_XT + (32 * d0 + r32) * 528 + (32 * j + 16 * ks + 4 * hi) * 2;
                    const u32x2 xa = *(const LAS u32x2*)xp, xb = *(const LAS u32x2*)(xp + 16);
                    const bf16x8 xf = __builtin_bit_cast(bf16x8, (u32x4){xa.x, xa.y, xb.x, xb.y});
                    o[d0] = __builtin_amdgcn_mfma_f32_32x32x16_bf16(xf, pf, o[d0], 0, 0, 0);
                }
            }
        }
        {
            unsigned* yd = YD + ((size_t)u * 8 + wid) * 1024 + lane;
#pragma unroll
            for (int d0 = 0; d0 < 2; ++d0)
#pragma unroll
                for (int r = 0; r < 16; r += 2) yd[(d0 * 8 + (r >> 1)) * 64] = pk2(o[d0][r], o[d0][r + 1]);
        }
        {
            const int pt = wid & 1, nt = wid >> 1;
            f32x16 st = f32x16{};
            const bf16* bp = BT + (size_t)((b * 4 + g) * 128 + 32 * nt + r32) * SEQ + c * 256 + 8 * hi;
#pragma unroll 4
            for (int ks = 0; ks < 16; ++ks) {
                const u32x4 xr = *(LAS u32x4*)(lds + L_XT + (32 * pt + r32) * 528 + (16 * ks + 8 * hi) * 2);
                const f32x4 wa = *(LAS f32x4*)(lds + L_WG + (16 * ks + 8 * hi) * 4), wb = *(LAS f32x4*)(lds + L_WG + (16 * ks + 8 * hi + 4) * 4);
                u32x4 xs;
                xs.x = pk2(bflo(xr.x) * wa[0], bfhi(xr.x) * wa[1]); xs.y = pk2(bflo(xr.y) * wa[2], bfhi(xr.y) * wa[3]);
                xs.z = pk2(bflo(xr.z) * wb[0], bfhi(xr.z) * wb[1]); xs.w = pk2(bflo(xr.w) * wb[2], bfhi(xr.w) * wb[3]);
                const bf16x8 bfr = *(const bf16x8*)(bp + 16 * ks);
                st = __builtin_amdgcn_mfma_f32_32x32x16_bf16(__builtin_bit_cast(bf16x8, xs), bfr, st, 0, 0, 0);
            }
            float* sp = ST + (size_t)u * 8192 + 32 * nt + r32;
#pragma unroll
            for (int r = 0; r < 16; ++r) sp[(32 * pt + crow(r, hi)) * 128] = st[r];
        }
    }
}

__device__ __forceinline__ void ssd_scan_phase(const Args& a, int bid, int G, int tid) {
    unsigned char* ws = a.ws; asm volatile("" : "+s"(ws));
    const float* ST = (const float*)(ws + WS_ST); bf16* SIN = (bf16*)(ws + WS_SIN); const float* ACS = (const float*)(ws + WS_ACS);
    for (int gt = bid * 512 + tid; gt < 131072; gt += G * 512) {
        const int b = gt >> 16, h = (gt >> 11) & 31, q4 = gt & 2047;
        f32x4 v[32];
#pragma unroll
        for (int c = 0; c < 32; ++c) v[c] = *(const f32x4*)(ST + ((size_t)((b * 32 + c) * 32 + h)) * 8192 + q4 * 4);
        f32x4 run = (f32x4){0.f, 0.f, 0.f, 0.f};
#pragma unroll
        for (int c = 0; c < 32; ++c) {
            u32x2 p; p.x = pk2(run[0], run[1]); p.y = pk2(run[2], run[3]);
            *(u32x2*)(SIN + ((size_t)((b * 32 + c) * 32 + h)) * 8192 + q4 * 4) = p;
            const float dec = __expf(ACS[(size_t)(b * 32 + h) * SEQ + c * 256 + 255]);
            run = run * dec + v[c];
        }
    }
}

__device__ __forceinline__ void ssd_out_phase(const Args& a, int bid, int G, int tid, int wid, int lane) {
    unsigned char* ws = a.ws; asm volatile("" : "+s"(ws));
    const bf16* CMm = (const bf16*)(ws + WS_CM); const bf16* SIN = (const bf16*)(ws + WS_SIN); const bf16* Z = (const bf16*)(ws + WS_Z);
    const unsigned* YD = (const unsigned*)(ws + WS_YD); const float* ACS = (const float*)(ws + WS_ACS); bf16* Y = (bf16*)(ws + WS_Y);
    const int r32 = lane & 31, hi = lane >> 5;
    for (int u = bid; u < 256; u += G) {
        const int b = u >> 7, c = (u >> 2) & 31, g = u & 3;
        const int l = 32 * wid + r32; const size_t row = (size_t)b * SEQ + c * 256 + l;
        bf16x8 cf[8];
#pragma unroll
        for (int ks = 0; ks < 8; ++ks) cf[ks] = *(const bf16x8*)(CMm + row * 512 + g * 128 + 16 * ks + 8 * hi);
        float ssq = 0.f;
        for (int rr = 0; rr < 8; ++rr) {
            const int h = 8 * g + rr; const int uu = (b * 32 + c) * 32 + h;
            const float dec = __expf(ACS[(size_t)(b * 32 + h) * SEQ + c * 256 + l]);
            f32x16 o[2]; o[0] = f32x16{}; o[1] = f32x16{};
#pragma unroll
            for (int d0 = 0; d0 < 2; ++d0)
#pragma unroll
                for (int ks = 0; ks < 8; ++ks) {
                    const bf16x8 sa = *(const bf16x8*)(SIN + (size_t)uu * 8192 + (32 * d0 + r32) * 128 + 16 * ks + 8 * hi);
                    o[d0] = __builtin_amdgcn_mfma_f32_32x32x16_bf16(sa, cf[ks], o[d0], 0, 0, 0);
                }
            const unsigned* yd = YD + ((size_t)uu * 8 + wid) * 1024 + lane;
#pragma unroll
            for (int d0 = 0; d0 < 2; ++d0)
#pragma unroll
                for (int i = 0; i < 4; ++i) {
                    const int col = 64 * h + 32 * d0 + 8 * i + 4 * hi;
                    const u32x2 z2 = *(const u32x2*)(Z + row * 2048 + col);
                    const unsigned y01 = yd[(d0 * 8 + 2 * i) * 64], y23 = yd[(d0 * 8 + 2 * i + 1) * 64];
                    const float y0 = (o[d0][4 * i] * dec + bflo(y01)) * siluf(bflo(z2.x));
                    const float y1 = (o[d0][4 * i + 1] * dec + bfhi(y01)) * siluf(bfhi(z2.x));
                    const float y2 = (o[d0][4 * i + 2] * dec + bflo(y23)) * siluf(bflo(z2.y));
                    const float y3 = (o[d0][4 * i + 3] * dec + bfhi(y23)) * siluf(bfhi(z2.y));
                    ssq += (y0 * y0 + y1 * y1) + (y2 * y2 + y3 * y3);
                    u32x2 p; p.x = pk2(y0, y1); p.y = pk2(y2, y3);
                    *(u32x2*)(Y + row * 2048 + col) = p;
                }
        }
        ssq += __shfl_xor(ssq, 32);
        const float rstd = 1.f / sqrtf(ssq * (1.f / 512.f) + LN_EPS);
        asm volatile("s_waitcnt vmcnt(0)" ::: "memory");
        for (int rr = 0; rr < 8; ++rr) {
#pragma unroll
            for (int d0 = 0; d0 < 2; ++d0)
#pragma unroll
                for (int i = 0; i < 4; ++i) {
                    const int col = 64 * (8 * g + rr) + 32 * d0 + 8 * i + 4 * hi;
                    u32x2* yp = (u32x2*)(Y + row * 2048 + col);
                    const u32x2 v = *yp; u32x2 p;
                    p.x = pk2(bflo(v.x) * rstd, bfhi(v.x) * rstd); p.y = pk2(bflo(v.y) * rstd, bfhi(v.y) * rstd);
                    *yp = p;
                }
        }
    }
}

__device__ __forceinline__ void fox_cum_phase(const Args& a, LAS unsigned char* lds, int bid, int G, int tid, int wid, int lane) {
    unsigned char* ws = a.ws; asm volatile("" : "+s"(ws));
    const float* LF = (const float*)(ws + WS_LF); float* CUM = (float*)(ws + WS_CUM);
    LAS float* wt = (LAS float*)lds;
    for (int sq = bid; sq < 32; sq += G) {
        __syncthreads();
        const float* src = LF + (size_t)sq * SEQ + tid * 16;
        f32x4 v[4]; float run = 0.f;
#pragma unroll
        for (int k = 0; k < 4; ++k) { v[k] = *(const f32x4*)(src + 4 * k);
#pragma unroll
            for (int q = 0; q < 4; ++q) { run += v[k][q]; v[k][q] = run; } }
        float tot = run;
#pragma unroll
        for (int o = 1; o < 64; o <<= 1) { const float t = __shfl_up(tot, o); if (lane >= o) tot += t; }
        if (lane == 63) wt[wid] = tot;
        __syncthreads();
        float base = tot - run;
        for (int w = 0; w < wid; ++w) base += wt[w];
        float* dst = CUM + (size_t)sq * SEQ + tid * 16;
#pragma unroll
        for (int k = 0; k < 4; ++k) *(f32x4*)(dst + 4 * k) = (v[k] + base) * LOG2E;
    }
}
__device__ __forceinline__ void moba_kmean_phase(const Args& a, int bid, int G, int tid) {
    unsigned char* ws = a.ws; asm volatile("" : "+s"(ws));
    const bf16* K = (const bf16*)(ws + WS_K); float* KM = (float*)(ws + WS_KM);
    for (int u = bid; u < 64; u += G) {
        const int b = u >> 5, j = u & 31;
        const unsigned* src = (const unsigned*)(K + (size_t)(b * SEQ + j * 256) * DM) + tid;
        float s0 = 0.f, s1 = 0.f;
#pragma unroll 8
        for (int r = 0; r < 256; ++r) { const unsigned v = src[(size_t)r * 512]; s0 += bflo(v); s1 += bfhi(v); }
        const int col = 2 * tid, h = col >> 6, d = col & 63;
        float* dst = KM + ((size_t)((b * 16 + h) * 32 + j)) * 64 + d;
        dst[0] = s0 * (1.f / 256.f); dst[1] = s1 * (1.f / 256.f);
    }
}

template <bool FOX>
__device__ __forceinline__ void attn_phase(const Args& a, LAS unsigned char* lds, int bid, int G, int tid, int wid, int lane) {
    unsigned char* ws = a.ws; asm volatile("" : "+s"(ws));
    const bf16* Q = (const bf16*)(ws + WS_Q); const bf16* K = (const bf16*)(ws + WS_K); const bf16* VT = (const bf16*)(ws + WS_VT);
    const float* CUM = (const float*)(ws + WS_CUM); const float* KM = (const float*)(ws + WS_KM); bf16* O = (bf16*)(ws + WS_O);
    constexpr int L_K = 0, L_V = 18432, L_CK = 36864, L_KM = 37376, L_UM = 45568, L_BL = 45584;
    const int r32 = lane & 31, hi = lane >> 5;
    const float NEG = -INFINITY;
    for (int ui = 0; ui < 4; ++ui) {
        const int v = bid + 0 * G;
        const int bh = v >> 3, sx = v & 7;
        const int qb = (ui == 0) ? sx : (ui == 1) ? 15 - sx : (ui == 2) ? 16 + sx : 31 - sx;
        const int b = bh >> 4, h = bh & 15;
        const int q0 = qb * 256, qw = q0 + wid * 32, q = qw + r32;
        __syncthreads();
        bf16x8 qf[4];
#pragma unroll
        for (int d0 = 0; d0 < 4; ++d0) qf[d0] = *(const bf16x8*)(Q + (size_t)(b * SEQ + q) * DM + h * 64 + 16 * d0 + 8 * hi);
        unsigned selmask = 0xffffffffu;
        if (!FOX) {
            *(LAS f32x4*)(lds + L_KM + tid * 16) = *(const f32x4*)(KM + (size_t)bh * 2048 + tid * 4);
            if (tid == 0) *(LAS unsigned*)(lds + L_UM) = 0u;
            __syncthreads();
            float qv[32];
#pragma unroll
            for (int d0 = 0; d0 < 4; ++d0) { const u32x4 t = __builtin_bit_cast(u32x4, qf[d0]);
                qv[d0 * 8 + 0] = bflo(t.x); qv[d0 * 8 + 1] = bfhi(t.x); qv[d0 * 8 + 2] = bflo(t.y); qv[d0 * 8 + 3] = bfhi(t.y);
                qv[d0 * 8 + 4] = bflo(t.z); qv[d0 * 8 + 5] = bfhi(t.z); qv[d0 * 8 + 6] = bflo(t.w); qv[d0 * 8 + 7] = bfhi(t.w); }
            float v1 = NEG, v2 = NEG, v3 = NEG; int i1 = -1, i2 = -1, i3 = -1;
            for (int j = 0; j < qb; ++j) {
                float part = 0.f;
#pragma unroll
                for (int d0 = 0; d0 < 4; ++d0) {
                    const f32x4 k0 = *(LAS f32x4*)(lds + L_KM + (j * 64 + 16 * d0 + 8 * hi) * 4), k1 = *(LAS f32x4*)(lds + L_KM + (j * 64 + 16 * d0 + 8 * hi + 4) * 4);
                    part += qv[d0 * 8 + 0] * k0[0] + qv[d0 * 8 + 1] * k0[1] + qv[d0 * 8 + 2] * k0[2] + qv[d0 * 8 + 3] * k0[3]
                          + qv[d0 * 8 + 4] * k1[0] + qv[d0 * 8 + 5] * k1[1] + qv[d0 * 8 + 6] * k1[2] + qv[d0 * 8 + 7] * k1[3];
                }
                const float gsc = part + __shfl_xor(part, 32);
                if (gsc > v1) { v3 = v2; i3 = i2; v2 = v1; i2 = i1; v1 = gsc; i1 = j; }
                else if (gsc > v2) { v3 = v2; i3 = i2; v2 = gsc; i2 = j; }
                else if (gsc > v3) { v3 = gsc; i3 = j; }
            }
            selmask = (i1 >= 0 ? (1u << i1) : 0u) | (i2 >= 0 ? (1u << i2) : 0u) | (i3 >= 0 ? (1u << i3) : 0u);
            __hip_atomic_fetch_or((LAS unsigned*)(lds + L_UM), selmask, __ATOMIC_RELAXED, __HIP_MEMORY_SCOPE_WORKGROUP);
            __syncthreads();
        }
        if (tid == 0) {
            unsigned um = FOX ? ((qb == 0) ? 0u : (0xffffffffu >> (32 - qb))) : *(LAS unsigned*)(lds + L_UM);
            um |= (1u << qb);
            int n = 0;
            for (int j = 0; j <= qb; ++j) if ((um >> j) & 1u) { *(LAS int*)(lds + L_BL + 4 + 4 * n) = j; ++n; }
            *(LAS int*)(lds + L_BL) = n;
        }
        __syncthreads();
        const int NTT = 4 * *(LAS int*)(lds + L_BL);
        float cq = 0.f;
        if (FOX) cq = CUM[(size_t)bh * SEQ + q];
        float m = NEG, lsum = 0.f;
        f32x16 o[2]; o[0] = f32x16{}; o[1] = f32x16{};
        const int srow = tid >> 3, spc = tid & 7;
        const bf16* kg = K + (size_t)(b * SEQ + srow) * DM + h * 64 + spc * 8;
        const bf16* vg = VT + (size_t)(bh * 64 + srow) * SEQ + spc * 8;
        const float* cg_ = CUM + (size_t)bh * SEQ + (tid & 63);
        u32x4 kreg, vreg; float creg = 0.f;
        {
            const int blk = *(LAS int*)(lds + L_BL + 4); const int k0 = blk * 256;
            kreg = *(const u32x4*)(kg + (size_t)k0 * DM); vreg = *(const u32x4*)(vg + k0);
            if (FOX && tid < 64) creg = cg_[k0];
            *(LAS u32x4*)(lds + L_K + srow * 144 + spc * 16) = kreg; *(LAS u32x4*)(lds + L_V + srow * 144 + spc * 16) = vreg;
            if (FOX && tid < 64) *(LAS float*)(lds + L_CK + tid * 4) = creg;
        }
        __syncthreads();
        for (int ti = 0; ti < NTT; ++ti) {
            const int cur = ti & 1;
            const int blk = *(LAS int*)(lds + L_BL + 4 + 4 * (ti >> 2)); const int k0 = blk * 256 + (ti & 3) * 64;
            const bool more = ti + 1 < NTT;
            if (more) {
                const int nblk = *(LAS int*)(lds + L_BL + 4 + 4 * ((ti + 1) >> 2)); const int nk0 = nblk * 256 + ((ti + 1) & 3) * 64;
                kreg = *(const u32x4*)(kg + (size_t)nk0 * DM); vreg = *(const u32x4*)(vg + nk0);
                if (FOX && tid < 64) creg = cg_[nk0];
            }
            const bool isown = (blk == qb);
            bool active;
            if (isown) active = (k0 <= qw + 31);
            else active = FOX ? true : (__ballot((selmask >> blk) & 1u) != 0ull);
            if (active) {
                const LAS unsigned char* kb = lds + L_K + cur * 9216; const LAS unsigned char* vb = lds + L_V + cur * 9216;
                f32x16 s0 = f32x16{}, s1 = f32x16{};
#pragma unroll
                for (int d0 = 0; d0 < 4; ++d0) {
                    const bf16x8 kf0 = *(const LAS bf16x8*)(kb + r32 * 144 + (16 * d0 + 8 * hi) * 2);
                    const bf16x8 kf1 = *(const LAS bf16x8*)(kb + (32 + r32) * 144 + (16 * d0 + 8 * hi) * 2);
                    s0 = __builtin_amdgcn_mfma_f32_32x32x16_bf16(kf0, qf[d0], s0, 0, 0, 0);
                    s1 = __builtin_amdgcn_mfma_f32_32x32x16_bf16(kf1, qf[d0], s1, 0, 0, 0);
                }
                if (FOX) {
                    const LAS unsigned char* cb = lds + L_CK + cur * 256;
#pragma unroll
                    for (int i = 0; i < 4; ++i) {
                        const f32x4 c0 = *(const LAS f32x4*)(cb + (8 * i + 4 * hi) * 4), c1 = *(const LAS f32x4*)(cb + (32 + 8 * i + 4 * hi) * 4);
#pragma unroll
                        for (int t = 0; t < 4; ++t) { s0[4 * i + t] += cq - c0[t]; s1[4 * i + t] += cq - c1[t]; }
                    }
                }
                if (isown) {
#pragma unroll
                    for (int r = 0; r < 16; ++r) { const int key = k0 + crow(r, hi); if (key > q) s0[r] = NEG; if (key + 32 > q) s1[r] = NEG; }
                } else if (!FOX) {
                    if (!((selmask >> blk) & 1u)) {
#pragma unroll
                        for (int r = 0; r < 16; ++r) { s0[r] = NEG; s1[r] = NEG; }
                    }
                }
                float mx = fmaxf(s0[0], s1[0]);
#pragma unroll
                for (int r = 1; r < 16; ++r) mx = fmaxf(mx, fmaxf(s0[r], s1[r]));
                mx = fmaxf(mx, __shfl_xor(mx, 32));
                const float mnew = fmaxf(m, mx);
                const float msafe = (mnew == NEG) ? 0.f : mnew;
                const float f = __builtin_amdgcn_exp2f(m - msafe);
                m = mnew;
                float ps = 0.f;
#pragma unroll
                for (int r = 0; r < 16; ++r) { s0[r] = __builtin_amdgcn_exp2f(s0[r] - msafe); s1[r] = __builtin_amdgcn_exp2f(s1[r] - msafe); ps += s0[r] + s1[r]; }
                lsum = lsum * f + ps;
#pragma unroll
                for (int r = 0; r < 16; ++r) { o[0][r] *= f; o[1][r] *= f; }
#pragma unroll
                for (int kt = 0; kt < 2; ++kt)
#pragma unroll
                    for (int ks = 0; ks < 2; ++ks) {
                        u32x4 pw;
                        if (kt == 0) { pw.x = pk2(s0[8 * ks], s0[8 * ks + 1]); pw.y = pk2(s0[8 * ks + 2], s0[8 * ks + 3]); pw.z = pk2(s0[8 * ks + 4], s0[8 * ks + 5]); pw.w = pk2(s0[8 * ks + 6], s0[8 * ks + 7]); }
                        else { pw.x = pk2(s1[8 * ks], s1[8 * ks + 1]); pw.y = pk2(s1[8 * ks + 2], s1[8 * ks + 3]); pw.z = pk2(s1[8 * ks + 4], s1[8 * ks + 5]); pw.w = pk2(s1[8 * ks + 6], s1[8 * ks + 7]); }
                        const bf16x8 pf = __builtin_bit_cast(bf16x8, pw);
#pragma unroll
                        for (int d0 = 0; d0 < 2; ++d0) {
                            const LAS unsigned char* vp = vb + (32 * d0 + r32) * 144 + (32 * kt + 16 * ks + 4 * hi) * 2;
                            const u32x2 xa = *(const LAS u32x2*)vp, xb = *(const LAS u32x2*)(vp + 16);
                            const bf16x8 vf = __builtin_bit_cast(bf16x8, (u32x4){xa.x, xa.y, xb.x, xb.y});
                            o[d0] = __builtin_amdgcn_mfma_f32_32x32x16_bf16(vf, pf, o[d0], 0, 0, 0);
                        }
                    }
            }
            if (more) {
                const int nb = cur ^ 1;
                *(LAS u32x4*)(lds + L_K + nb * 9216 + srow * 144 + spc * 16) = kreg; *(LAS u32x4*)(lds + L_V + nb * 9216 + srow * 144 + spc * 16) = vreg;
                if (FOX && tid < 64) *(LAS float*)(lds + L_CK + nb * 256 + tid * 4) = creg;
            }
            __syncthreads();
        }
        lsum += __shfl_xor(lsum, 32);
        const float inv = 1.f / lsum;
        bf16* op = O + (size_t)(b * SEQ + q) * DM + h * 64;
#pragma unroll
        for (int d0 = 0; d0 < 2; ++d0)
#pragma unroll
            for (int i = 0; i < 4; ++i) {
                u32x2 p; p.x = pk2(o[d0][4 * i] * inv, o[d0][4 * i + 1] * inv); p.y = pk2(o[d0][4 * i + 2] * inv, o[d0][4 * i + 3] * inv);
                *(u32x2*)(op + 32 * d0 + 8 * i + 4 * hi) = p;
            }
    }
}

enum { OP_INIT = 0, OP_FFN_UP, OP_FFN_DOWN, OP_LN, OP_SSM_IN, OP_CONV, OP_DIAG, OP_SCAN, OP_YOFF, OP_MIX_OUT, OP_ATT_IN, OP_AUX, OP_ATTN };
constexpr int N_PHASES = 49;

__global__ void __launch_bounds__(512, 2) fwd_mega(Args a) {
    extern __shared__ __attribute__((aligned(16))) unsigned char smem[];
    LAS unsigned char* lds = (LAS unsigned char*)smem;
    cg::grid_group grid = cg::this_grid();
    const int tid0 = threadIdx.x;
    const int G0 = gridDim.x, bid0 = blockIdx.x;
    for (int ph = a.ph_lo; ph < a.ph_hi; ++ph) {
        int tid = tid0, G = G0, bid = bid0; unsigned char* ws = a.ws;
        asm volatile("" : "+v"(tid)); asm volatile("" : "+s"(G), "+s"(bid), "+s"(ws));
        const int lane = tid & 63, wid = __builtin_amdgcn_readfirstlane(tid >> 6);
        const int gw = bid * 8 + wid, NGW = G * 8;
        int L = 0, op = OP_INIT, sub = 0;
        if (ph > 0) {
            int p = ph - 1;
            if (p >= 35) { L = 3; p -= 35; } else if (p >= 24) { L = 2; p -= 24; } else if (p >= 13) { L = 1; p -= 13; } else L = 0;
            const bool ssm = (L % 3) == 0;
            const int nmix = ssm ? 7 : 5;
            if (p < 3) { op = p == 0 ? OP_FFN_UP : p == 1 ? OP_FFN_DOWN : OP_LN; sub = 0; }
            else if (p < 3 + nmix) {
                const int q = p - 3;
                if (ssm) { op = q == 0 ? OP_SSM_IN : q == 1 ? OP_CONV : q == 2 ? OP_DIAG : q == 3 ? OP_SCAN : q == 4 ? OP_YOFF : q == 5 ? OP_MIX_OUT : OP_LN; }
                else { op = q == 0 ? OP_ATT_IN : q == 1 ? OP_AUX : q == 2 ? OP_ATTN : q == 3 ? OP_MIX_OUT : OP_LN; }
                sub = 1;
            } else { const int q = p - 3 - nmix; op = q == 0 ? OP_FFN_UP : q == 1 ? OP_FFN_DOWN : OP_LN; sub = (op == OP_LN) ? 2 : 1; }
        }
        const int kind = L % 3, jj = L / 3;
        const bool is_gemm = (op == OP_FFN_UP || op == OP_FFN_DOWN || op == OP_SSM_IN || op == OP_MIX_OUT || op == OP_ATT_IN);
        if (is_gemm) {
            pg8::Gemm g; Epi E; E.mode = 0; E.w = 1.f; E.out = a.out; E.ws = ws; E.bias = nullptr;
            g.M = MTOK; int kc = 0;
            if (op == OP_FFN_UP) { g.A = (const bf16*)(ws + WS_H16); g.Bt = (const bf16*)(ws + (sub ? WS_WGU1 : WS_WGU0)); g.N = 5632; E.mode = 0; }
            else if (op == OP_FFN_DOWN) { g.A = (const bf16*)(ws + WS_ACT); g.Bt = (const bf16*)(ws + (sub ? WS_WD1 : WS_WD0)); g.N = DM; kc = 1; E.mode = 1; E.w = 0.5f; }
            else if (op == OP_SSM_IN) { g.A = (const bf16*)(ws + WS_H16); g.Bt = (const bf16*)(ws + WS_WIN); g.N = 5376; E.mode = 2; E.bias = a.ssm_dtb + jj * 32; }
            else if (op == OP_ATT_IN) { g.A = (const bf16*)(ws + WS_H16); g.Bt = (const bf16*)(ws + WS_WIN); g.N = kind == 1 ? 3328 : 3072; E.mode = 3; E.bias = a.fox_bf + jj * 16; }
            else { g.Bt = (const bf16*)(ws + WS_WOUT); g.N = DM; E.mode = 1; E.w = 1.f;
                   if (kind == 0) { g.A = (const bf16*)(ws + WS_Y); kc = 2; } else { g.A = (const bf16*)(ws + WS_O); } }
            pg8::StaticOrder S; S.init(g.M, g.N, G, bid);
            if (kc == 0) { g.K = DM; pg8::gemm_phase<Epi, pg8::StaticOrder, true, true>(lds, g, S, E); }
            else { EpiRes E1; E1.w = E.w; E1.out = a.out; if (kc == 1) { g.K = DFF; pg8::gemm_phase<EpiRes, pg8::StaticOrder, true, true>(lds, g, S, E1); } else { g.K = 2048; pg8::gemm_phase<EpiRes, pg8::StaticOrder, true, true>(lds, g, S, E1); } }
        } else if (op == OP_INIT) {
            convert_layer(a, 0, lds, gw, NGW, wid, lane);
            const f32x4* xs = (const f32x4*)a.x; f32x4* od = (f32x4*)a.out; u32x2* hd = (u32x2*)(ws + WS_H16);
            for (int i = bid * 512 + tid; i < MTOK * DM / 4; i += G * 512) { const f32x4 v = xs[i]; od[i] = v; u32x2 p; p.x = pk2(v[0], v[1]); p.y = pk2(v[2], v[3]); hd[i] = p; }
        } else if (op == OP_LN) {
            ln_pass(a.out, (bf16*)(ws + WS_H16), a.lng + (size_t)(L * 3 + sub) * DM, a.lnb + (size_t)(L * 3 + sub) * DM, gw, NGW, lane);
            if (sub == 2 && L < 3) convert_layer(a, L + 1, lds, gw, NGW, wid, lane);
        } else if (op == OP_CONV) { conv_phase(a, jj, bid, G, tid, wid, lane);
        } else if (op == OP_DIAG) { ssd_diag_phase(a, jj, lds, bid, G, tid, wid, lane);
        } else if (op == OP_SCAN) { ssd_scan_phase(a, bid, G, tid);
        } else if (op == OP_YOFF) { ssd_out_phase(a, bid, G, tid, wid, lane);
        } else if (op == OP_AUX) { if (kind == 1) fox_cum_phase(a, lds, bid, G, tid, wid, lane); else moba_kmean_phase(a, bid, G, tid);
        } else if (op == OP_ATTN) { if (kind == 1) attn_phase<true>(a, lds, bid, G, tid, wid, lane); else attn_phase<false>(a, lds, bid, G, tid, wid, lane); }
        if (ph + 1 < a.ph_hi) grid.sync();
    }
}

extern "C" void kernel_launch(void* const* d_in, const int* in_sizes, int n_in, void* d_out, int out_size, void* d_ws, size_t ws_size, hipStream_t stream) {
    static int grid = 0;
    if (grid == 0) {
        if (n_in != 19 || out_size != MTOK * DM || ws_size < WS_END) { fprintf(stderr, "kernel_launch: unexpected shapes (n_in %d out %d ws %zu)\n", n_in, out_size, ws_size); grid = -1; return; }
        int dev = 0, cus = 0, per_cu = 0;
        hipGetDevice(&dev); hipDeviceGetAttribute(&cus, hipDeviceAttributeMultiprocessorCount, dev);
        if (hipFuncSetAttribute((const void*)fwd_mega, hipFuncAttributeMaxDynamicSharedMemorySize, LDS_BYTES) != hipSuccess) { fprintf(stderr, "kernel_launch: hipFuncSetAttribute failed\n"); grid = -1; return; }
        hipOccupancyMaxActiveBlocksPerMultiprocessor(&per_cu, (const void*)fwd_mega, 512, LDS_BYTES);
        (void)hipGetLastError();
        if (cus != 256 || per_cu < 1) fprintf(stderr, "kernel_launch: note: cus %d per_cu %d (built for 256 x 1)\n", cus, per_cu);
        grid = 256;
    }
    if (grid < 0) return;
    Args a{};
    a.x = (const float*)d_in[0]; a.wg = (const float*)d_in[1]; a.wu = (const float*)d_in[2]; a.wd = (const float*)d_in[3]; a.lng = (const float*)d_in[4]; a.lnb = (const float*)d_in[5];
    a.ssm_win = (const float*)d_in[6]; a.ssm_cw = (const float*)d_in[7]; a.ssm_cb = (const float*)d_in[8]; a.ssm_dtb = (const float*)d_in[9]; a.ssm_alog = (const float*)d_in[10];
    a.ssm_d = (const float*)d_in[11]; a.ssm_nw = (const float*)d_in[12]; a.ssm_wout = (const float*)d_in[13]; a.fox_win = (const float*)d_in[14]; a.fox_bf = (const float*)d_in[15];
    a.fox_wout = (const float*)d_in[16]; a.moba_win = (const float*)d_in[17]; a.moba_wout = (const float*)d_in[18];
    a.out = (float*)d_out; a.ws = (unsigned char*)d_ws;
#if MK_MULTI
    for (int ph = 0; ph < N_PHASES; ++ph) { a.ph_lo = ph; a.ph_hi = ph + 1; hipLaunchKernelGGL(fwd_mega, dim3(grid), dim3(512), LDS_BYTES, stream, a); }
#else
    a.ph_lo = 0; a.ph_hi = N_PHASES;
    void* args[] = {&a};
    hipError_t e = hipLaunchCooperativeKernel((const void*)fwd_mega, dim3(grid), dim3(512), args, LDS_BYTES, stream);
    if (e != hipSuccess) fprintf(stderr, "cooperative launch failed: %s\n", hipGetErrorString(e));
#endif
}
```

```cpp
#include <hip/hip_runtime.h>
#include <hip/hip_cooperative_groups.h>
#include <cstdio>
#include <cstdint>
namespace cg = cooperative_groups;
#ifndef MK_MULTI
#define MK_MULTI 0
#endif
namespace pg8 {
#define PG8_LAS __attribute__((address_space(3)))
typedef unsigned short bf16_t;
typedef short bf16x8 __attribute__((ext_vector_type(8)));
typedef float f32x4 __attribute__((ext_vector_type(4)));
typedef unsigned u32x4 __attribute__((ext_vector_type(4)));
constexpr int BM = 256, BK = 64, HALF = 128, HTB = HALF * BK * 2  , STAGE_BYTES = 8 * HTB, NXCD = 8, WGM = 8;

__host__ __device__ __forceinline__ int lds_byte(int r, int c) { const int st = (r >> 4) * 2 + (c >> 5), rr = r & 15, cc = c & 31, ob = rr * 64 + cc * 2; return st * 1024 + (ob ^ (((ob >> 9) & 1) << 5)); }
__host__ __device__ __forceinline__ void stage_rc(int b, int& R, int& C) { const int st = b / 1024, sb = b % 1024, swz = sb ^ (((sb >> 9) & 1) << 5); R = (st >> 1) * 16 + swz / 64; C = (st & 1) * 32 + (swz % 64) / 2; }
__host__ __device__ __forceinline__ int perm32(int rho) { const int n = rho >> 4, i = rho & 15; return 8 * (i >> 2) + 4 * n + (i & 3); }

struct Unit { int pm, pn; };
struct Gemm { const bf16_t* A; const bf16_t* Bt; int M, N, K; };

struct StaticOrder {
    int nM, nN, nwg, G, c;
    __host__ __device__ void init(int M, int N, int G_, int c_) { nM = M / BM; nN = N / BM; nwg = nM * nN; G = G_; c = c_; }
    __host__ __device__ bool next(int i, Unit& u) const {
        const long L = (long)i * G + c; if (L >= nwg) return false;
        int wgid = (int)L; { const int q = nwg / NXCD, r = nwg % NXCD, xcd = wgid % NXCD, off = wgid / NXCD; wgid = (xcd < r ? xcd * (q + 1) : r * (q + 1) + (xcd - r) * q) + off; }
        const int nig = WGM * nN, gid = wgid / nig, fm = gid * WGM, gsz = (nM - fm) < WGM ? (nM - fm) : WGM;
        u.pm = fm + ((wgid % nig) % gsz); u.pn = (wgid % nig) / gsz; return true;
    }
    __device__ __forceinline__ void a_ready(const Unit&) const {}
    __device__ __forceinline__ void done(const Unit&) const {}
};
template <class Epi, class Sched, bool ALIGN_EPI = false, bool SP2 = false>
__device__ __forceinline__ void gemm_phase(PG8_LAS unsigned char* lds, const Gemm g, const Sched& S, const Epi& E) {
    const int tid = threadIdx.x, wid = __builtin_amdgcn_readfirstlane(tid >> 6), lane = tid & 63, wr = wid >> 2, wc = wid & 3, fr = lane & 15, fq = lane >> 4;
    const int K = g.K, nt = K / BK;
    unsigned voffA[2], voffB[2];
#pragma unroll
    for (int i = 0; i < 2; ++i) { int R, C; stage_rc(tid * 16 + i * 8192, R, C); const int Rb = Epi::PERM ? ((R & ~31) + perm32(R & 31)) : R;
        voffA[i] = (unsigned)(R * K + C) * 2u; voffB[i] = (unsigned)(Rb * K + C) * 2u; }
    const size_t kstep = (size_t)(BK * 2);
    const size_t hstep = (size_t)HALF * K * 2;
    const size_t tstep = 2 * hstep;
    const unsigned ldsw = (unsigned)wid * 1024u;
    const int aoff = lds_byte(wr * 64 + fr, fq * 8), boff = lds_byte(wc * 32 + fr, fq * 8);
#define PG8_SA(b, h) (((b) * 2 + (h)) * HTB)
#define PG8_SB(b, h) ((4 + (b) * 2 + (h)) * HTB)
#define PG8_STAGE(bufoff, gbase, voff) do { _Pragma("unroll") for (int _i = 0; _i < 2; ++_i) \
        __builtin_amdgcn_global_load_lds((const unsigned*)((const char*)(gbase) + (voff)[_i]), (PG8_LAS unsigned*)(lds + (bufoff) + ldsw + _i * 8192), 16, 0, 0); } while (0)
#define PG8_LDA(dst, b, h) do { _Pragma("unroll") for (int m = 0; m < 4; ++m) _Pragma("unroll") for (int k = 0; k < 2; ++k) dst[m][k] = *(const PG8_LAS bf16x8*)(lds + PG8_SA(b, h) + aoff + m * 2048 + k * 1024); } while (0)
#define PG8_LDB(dst, b, h) do { _Pragma("unroll") for (int n = 0; n < 2; ++n) _Pragma("unroll") for (int k = 0; k < 2; ++k) dst[n][k] = *(const PG8_LAS bf16x8*)(lds + PG8_SB(b, h) + boff + n * 2048 + k * 1024); } while (0)
#define PG8_MMA(ai, bj, At, Bt) do { __builtin_amdgcn_s_setprio(1); _Pragma("unroll") for (int m = 0; m < 4; ++m) _Pragma("unroll") for (int n = 0; n < 2; ++n) _Pragma("unroll") for (int k = 0; k < 2; ++k) \
        acc[ai][bj][m][n] = __builtin_amdgcn_mfma_f32_16x16x32_bf16(Bt[n][k], At[m][k], acc[ai][bj][m][n], 0, 0, 0); __builtin_amdgcn_s_setprio(0); } while (0)
#define PG8_WAIT_V(n) asm volatile("s_waitcnt vmcnt(" #n ")" ::: "memory")
#define PG8_WAIT_L(n) asm volatile("s_waitcnt lgkmcnt(" #n ")" ::: "memory")
#define PG8_BAR __builtin_amdgcn_s_barrier()
#define PG8_SCHED __builtin_amdgcn_sched_barrier(0)
    Unit cur, nxt; int ui = 0;
    if (!S.next(0, cur)) return;
    f32x4 acc[2][2][4][2];
#pragma unroll
    for (int a = 0; a < 2; ++a)
#pragma unroll
        for (int b = 0; b < 2; ++b)
#pragma unroll
            for (int m = 0; m < 4; ++m)
#pragma unroll
                for (int n = 0; n < 2; ++n) acc[a][b][m][n] = (f32x4){0.f, 0.f, 0.f, 0.f};
    bf16x8 At[4][2], B0[2][2], B1[2][2];
    const char* cA = (const char*)g.A + (size_t)cur.pm * tstep; const char* cB = (const char*)g.Bt + (size_t)cur.pn * tstep;
    S.a_ready(cur);
    if constexpr (SP2) {
        PG8_STAGE(PG8_SB(0, 0), cB, voffB); PG8_STAGE(PG8_SB(0, 1), cB + hstep, voffB); PG8_STAGE(PG8_SA(0, 0), cA, voffA); PG8_STAGE(PG8_SA(0, 1), cA + hstep, voffA);
        if (wr == 1) PG8_BAR;
        PG8_WAIT_V(2); PG8_BAR;
        PG8_STAGE(PG8_SB(1, 0), cB + kstep, voffB); PG8_STAGE(PG8_SA(1, 0), cA + kstep, voffA); PG8_STAGE(PG8_SB(1, 1), cB + hstep + kstep, voffB);
        PG8_WAIT_V(6); PG8_BAR;
    } else {
        PG8_STAGE(PG8_SB(0, 0), cB, voffB); PG8_STAGE(PG8_SA(0, 0), cA, voffA); PG8_STAGE(PG8_SB(0, 1), cB + hstep, voffB); PG8_STAGE(PG8_SA(0, 1), cA + hstep, voffA);
        if (wr == 1) PG8_BAR;
        PG8_WAIT_V(4); PG8_BAR;
        PG8_STAGE(PG8_SB(1, 0), cB + kstep, voffB); PG8_STAGE(PG8_SA(1, 0), cA + kstep, voffA); PG8_STAGE(PG8_SB(1, 1), cB + hstep + kstep, voffB);
        PG8_WAIT_V(6); PG8_BAR;
    }
    for (;;) {
        const bool has_next = S.next(ui + 1, nxt);
        const char* nA = has_next ? (const char*)g.A + (size_t)nxt.pm * tstep : cA; const char* nB = has_next ? (const char*)g.Bt + (size_t)nxt.pn * tstep : cB;
        for (int t = 0; t < nt; t += 2) {
            const bool last = (t == nt - 2);
            const char* a1 = cA + (size_t)(t + 1) * kstep;
            const char* a2 = last ? nA : cA + (size_t)(t + 2) * kstep; const char* b2 = last ? nB : cB + (size_t)(t + 2) * kstep;
            const char* a3 = a2 + kstep; const char* b3 = b2 + kstep;
            if (last && has_next) S.a_ready(nxt);
            if constexpr (SP2) {
            PG8_LDB(B0, 0, 0); PG8_LDB(B1, 0, 1); PG8_SCHED; PG8_LDA(At, 0, 0); PG8_STAGE(PG8_SA(1, 1), a1 + hstep, voffA);
            PG8_WAIT_V(8); PG8_WAIT_L(0); PG8_BAR; PG8_MMA(0, 0, At, B0); PG8_MMA(0, 1, At, B1); PG8_BAR; PG8_SCHED;
            PG8_LDA(At, 0, 1); PG8_STAGE(PG8_SB(0, 0), b2, voffB); PG8_STAGE(PG8_SB(0, 1), b2 + hstep, voffB); PG8_STAGE(PG8_SA(0, 0), a2, voffA);
            PG8_WAIT_V(8); PG8_WAIT_L(0); PG8_BAR; PG8_MMA(1, 0, At, B0); PG8_MMA(1, 1, At, B1); PG8_BAR; PG8_SCHED;
            PG8_LDB(B0, 1, 0); PG8_LDB(B1, 1, 1); PG8_SCHED; PG8_LDA(At, 1, 0); PG8_STAGE(PG8_SA(0, 1), a2 + hstep, voffA);
            PG8_WAIT_V(8); PG8_WAIT_L(0); PG8_BAR; PG8_MMA(0, 0, At, B0); PG8_MMA(0, 1, At, B1); PG8_BAR; PG8_SCHED;
            PG8_LDA(At, 1, 1); PG8_STAGE(PG8_SB(1, 0), b3, voffB); PG8_STAGE(PG8_SB(1, 1), b3 + hstep, voffB); PG8_STAGE(PG8_SA(1, 0), a3, voffA);
            PG8_WAIT_V(8); PG8_WAIT_L(0); PG8_BAR; PG8_MMA(1, 0, At, B0); PG8_MMA(1, 1, At, B1); PG8_BAR; PG8_SCHED;
            } else {
            PG8_LDB(B0, 0, 0); PG8_SCHED; PG8_LDA(At, 0, 0); PG8_STAGE(PG8_SA(1, 1), a1 + hstep, voffA);
            PG8_WAIT_L(8); PG8_BAR; PG8_WAIT_L(0); PG8_MMA(0, 0, At, B0); PG8_BAR; PG8_SCHED;
            PG8_LDB(B1, 0, 1); PG8_STAGE(PG8_SB(0, 0), b2, voffB);
            PG8_BAR; PG8_WAIT_L(0); PG8_MMA(0, 1, At, B1); PG8_BAR;
            PG8_LDA(At, 0, 1); PG8_STAGE(PG8_SA(0, 0), a2, voffA);
            PG8_BAR; PG8_WAIT_L(0); PG8_MMA(1, 0, At, B0); PG8_BAR; PG8_SCHED;
            PG8_STAGE(PG8_SB(0, 1), b2 + hstep, voffB);
            PG8_WAIT_V(6); PG8_BAR; PG8_MMA(1, 1, At, B1); PG8_BAR;
            PG8_LDB(B0, 1, 0); PG8_SCHED; PG8_LDA(At, 1, 0); PG8_STAGE(PG8_SA(0, 1), a2 + hstep, voffA);
            PG8_WAIT_L(8); PG8_BAR; PG8_WAIT_L(0); PG8_MMA(0, 0, At, B0); PG8_BAR; PG8_SCHED;
            PG8_LDB(B1, 1, 1); PG8_STAGE(PG8_SB(1, 0), b3, voffB);
            PG8_BAR; PG8_WAIT_L(0); PG8_MMA(0, 1, At, B1); PG8_BAR;
            PG8_LDA(At, 1, 1); PG8_STAGE(PG8_SA(1, 0), a3, voffA);
            PG8_BAR; PG8_WAIT_L(0); PG8_MMA(1, 0, At, B0); PG8_BAR; PG8_SCHED;
            PG8_STAGE(PG8_SB(1, 1), b3 + hstep, voffB);
            PG8_WAIT_V(6); PG8_BAR; PG8_MMA(1, 1, At, B1); PG8_BAR;
            }
        }
        if constexpr (ALIGN_EPI) { if (wr == 0) PG8_BAR; }
        if constexpr (!Epi::AFTER_DRAIN) { E(acc, cur, wr, wc, fr, fq); S.done(cur); }
        if (!has_next) break;
#pragma unroll
        for (int a = 0; a < 2; ++a)
#pragma unroll
            for (int b = 0; b < 2; ++b)
#pragma unroll
                for (int m = 0; m < 4; ++m)
#pragma unroll
                    for (int n = 0; n < 2; ++n) acc[a][b][m][n] = (f32x4){0.f, 0.f, 0.f, 0.f};
        cur = nxt; cA = nA; cB = nB; ++ui;
        if constexpr (ALIGN_EPI) { if (wr == 1) PG8_BAR; }
    }
    PG8_WAIT_V(0);
    if constexpr (!ALIGN_EPI) { if (wr == 0) PG8_BAR; }
    PG8_BAR;
    if constexpr (Epi::AFTER_DRAIN) { E.fused(acc, cur, wr, wc, fr, fq, lds, wid, lane); S.done(cur); }
#undef PG8_SA
#undef PG8_SB
#undef PG8_STAGE
#undef PG8_LDA
#undef PG8_LDB
#undef PG8_MMA
#undef PG8_WAIT_V
#undef PG8_WAIT_L
#undef PG8_BAR
#undef PG8_SCHED
}
}

#define LAS __attribute__((address_space(3)))
typedef unsigned short bf16;
typedef float f32x4 __attribute__((ext_vector_type(4)));
typedef float f32x16 __attribute__((ext_vector_type(16)));
typedef short bf16x8 __attribute__((ext_vector_type(8)));
typedef unsigned u32x4 __attribute__((ext_vector_type(4)));
typedef unsigned u32x2 __attribute__((ext_vector_type(2)));
typedef float f32x2_t __attribute__((ext_vector_type(2)));
typedef __bf16 bf16x2_t __attribute__((ext_vector_type(2)));

constexpr int SEQ = 8192, MTOK = 16384, DM = 1024, DFF = 2816;
constexpr float ALPHA = 1.6817928305074290f;
constexpr float LOG2E = 1.4426950408889634f;
constexpr float QSCALE = 0.125f * LOG2E;
constexpr float LN_EPS = 1e-5f;
constexpr size_t MiB = 1u << 20;
constexpr size_t WS_WGU0 = 0, WS_WD0 = 11 * MiB, WS_WGU1 = 33 * MiB / 2, WS_WD1 = 55 * MiB / 2, WS_WIN = 33 * MiB, WS_WOUT = 87 * MiB / 2;
constexpr size_t WS_H16 = 48 * MiB, WS_BM = 48 * MiB, WS_CM = 64 * MiB;
constexpr size_t WS_Z = 80 * MiB, WS_Q = 80 * MiB, WS_K = 112 * MiB, WS_ACT = 80 * MiB;
constexpr size_t WS_XBC = 144 * MiB, WS_ST = 144 * MiB, WS_SIN = 208 * MiB, WS_VT = 144 * MiB, WS_O = 176 * MiB;
constexpr size_t WS_XT = 240 * MiB, WS_Y = 240 * MiB, WS_BT = 304 * MiB, WS_YD = 320 * MiB;
constexpr size_t WS_CTL = 391 * MiB, CTL_BYTES = 65536;
constexpr int L_XBST = 147392;
constexpr size_t WS_DT = 384 * MiB, WS_ACS = 386 * MiB, WS_LF = 388 * MiB, WS_CUM = 389 * MiB, WS_KM = 390 * MiB, WS_END = 392 * MiB;
constexpr int LDS_BYTES = 147456;

__device__ __forceinline__ unsigned pk2(float lo, float hi) { f32x2_t v = {lo, hi}; bf16x2_t b = __builtin_convertvector(v, bf16x2_t); return __builtin_bit_cast(unsigned, b); }
__device__ __forceinline__ float bflo(unsigned x) { return __uint_as_float(x << 16); }
__device__ __forceinline__ float bfhi(unsigned x) { return __uint_as_float(x & 0xffff0000u); }
__device__ __forceinline__ float siluf(float v) { return v / (1.f + __expf(-v)); }
__device__ __forceinline__ int crow(int r, int hi) { return (r & 3) + 8 * (r >> 2) + 4 * hi; }
__device__ __forceinline__ float wave_sum(float v) {
#pragma unroll
    for (int o = 1; o < 64; o <<= 1) v += __shfl_xor(v, o);
    return v;
}

struct Args {
    const float *x, *wg, *wu, *wd, *lng, *lnb, *ssm_win, *ssm_cw, *ssm_cb, *ssm_dtb, *ssm_alog, *ssm_d, *ssm_nw, *ssm_wout,
        *fox_win, *fox_bf, *fox_wout, *moba_win, *moba_wout;
    float* out; unsigned char* ws; int ph_lo, ph_hi;
};

struct Epi {
    static constexpr bool PERM = false, AFTER_DRAIN = false;
    int mode; float w;
    float* out; unsigned char* ws; const float* bias;
    __device__ __forceinline__ void operator()(const pg8::f32x4 (&acc)[2][2][4][2], const pg8::Unit& u, int wr, int wc, int fr, int fq) const {
        const int row0 = u.pm * 256 + wr * 64 + fr;
        const int bb = u.pm >> 5;
        if (mode == 0) {
            const int colh = u.pn * 128 + wc * 32 + 4 * fq;
#pragma unroll
            for (int ai = 0; ai < 2; ++ai)
#pragma unroll
                for (int m = 0; m < 4; ++m) {
                    bf16* rp = (bf16*)(ws + WS_ACT) + (size_t)(row0 + ai * 128 + m * 16) * DFF + colh;
#pragma unroll
                    for (int n = 0; n < 2; ++n) {
                        const f32x4 g = acc[ai][0][m][n], uu = acc[ai][1][m][n];
                        u32x2 v; v.x = pk2(siluf(g[0]) * uu[0], siluf(g[1]) * uu[1]); v.y = pk2(siluf(g[2]) * uu[2], siluf(g[3]) * uu[3]);
                        *(u32x2*)(rp + 16 * n) = v;
                    }
                    asm volatile("" ::: "memory");
                }
        } else if (mode == 1) {
            const int col0 = u.pn * 256 + wc * 32 + 4 * fq;
#pragma unroll
            for (int ai = 0; ai < 2; ++ai)
#pragma unroll
                for (int m = 0; m < 4; ++m) {
                    float* rp = out + (size_t)(row0 + ai * 128 + m * 16) * DM + col0;
#pragma unroll
                    for (int bj = 0; bj < 2; ++bj)
#pragma unroll
                        for (int n = 0; n < 2; ++n) {
                            f32x4* p = (f32x4*)(rp + bj * 128 + 16 * n);
                            const f32x4 v = *p; *p = v * ALPHA + acc[ai][bj][m][n] * w;
                        }
                    asm volatile("" ::: "memory");
                }
        } else if (mode == 2) {
            if (u.pn < 20) {
                bf16* base; int ld, colt;
                if (u.pn < 8) { base = (bf16*)(ws + WS_Z); ld = 2048; colt = u.pn * 256; } else { base = (bf16*)(ws + WS_XBC); ld = 3072; colt = (u.pn - 8) * 256; }
                const int col0 = colt + wc * 32 + 4 * fq;
#pragma unroll
                for (int ai = 0; ai < 2; ++ai)
#pragma unroll
                    for (int m = 0; m < 4; ++m) {
                        bf16* rp = base + (size_t)(row0 + ai * 128 + m * 16) * ld + col0;
#pragma unroll
                        for (int bj = 0; bj < 2; ++bj)
#pragma unroll
                            for (int n = 0; n < 2; ++n) {
                                const f32x4 a = acc[ai][bj][m][n]; u32x2 v; v.x = pk2(a[0], a[1]); v.y = pk2(a[2], a[3]);
                                *(u32x2*)(rp + bj * 128 + 16 * n) = v;
                            }
                        asm volatile("" ::: "memory");
                    }
            } else if (wc == 0) {
#pragma unroll
                for (int n = 0; n < 2; ++n) {
                    const int hd = 16 * n + 4 * fq;
#pragma unroll
                    for (int j = 0; j < 4; ++j) {
                        const float bsv = bias[hd + j];
                        float* dp = (float*)(ws + WS_DT) + (size_t)(bb * 32 + hd + j) * SEQ;
#pragma unroll
                        for (int ai = 0; ai < 2; ++ai)
#pragma unroll
                            for (int m = 0; m < 4; ++m) {
                                const int s = (row0 + ai * 128 + m * 16) & (SEQ - 1);
                                const float xv = acc[ai][0][m][n][j] + bsv;
                                dp[s] = xv > 20.f ? xv : log1pf(__expf(xv));
                            }
                    }
                }
            }
        } else {
            if (u.pn < 8) {
                bf16* base = (bf16*)(ws + (u.pn < 4 ? WS_Q : WS_K)); const float sc = u.pn < 4 ? QSCALE : 1.f;
                const int col0 = (u.pn & 3) * 256 + wc * 32 + 4 * fq;
#pragma unroll
                for (int ai = 0; ai < 2; ++ai)
#pragma unroll
                    for (int m = 0; m < 4; ++m) {
                        bf16* rp = base + (size_t)(row0 + ai * 128 + m * 16) * DM + col0;
#pragma unroll
                        for (int bj = 0; bj < 2; ++bj)
#pragma unroll
                            for (int n = 0; n < 2; ++n) {
                                const f32x4 a = acc[ai][bj][m][n] * sc; u32x2 v; v.x = pk2(a[0], a[1]); v.y = pk2(a[2], a[3]);
                                *(u32x2*)(rp + bj * 128 + 16 * n) = v;
                            }
                        asm volatile("" ::: "memory");
                    }
            } else if (u.pn < 12) {
#pragma unroll
                for (int bj = 0; bj < 2; ++bj)
#pragma unroll
                    for (int n = 0; n < 2; ++n) {
                        const int c = (u.pn - 8) * 256 + bj * 128 + wc * 32 + 16 * n + 4 * fq;
#pragma unroll
                        for (int j = 0; j < 4; ++j) {
                            bf16* vp = (bf16*)(ws + WS_VT) + (size_t)((bb * 16 + ((c + j) >> 6)) * 64 + ((c + j) & 63)) * SEQ;
#pragma unroll
                            for (int ai = 0; ai < 2; ++ai)
#pragma unroll
                                for (int m = 0; m < 4; ++m) {
                                    const int s = (row0 + ai * 128 + m * 16) & (SEQ - 1);
                                    vp[s] = (bf16)(pk2(acc[ai][bj][m][n][j], 0.f) & 0xffffu);
                                }
                        }
                    }
            } else if (wc == 0 && fq < 4) {
#pragma unroll
                for (int j = 0; j < 4; ++j) {
                    const int hd = 4 * fq + j; const float bsv = bias[hd];
                    float* dp = (float*)(ws + WS_LF) + (size_t)(bb * 16 + hd) * SEQ;
#pragma unroll
                    for (int ai = 0; ai < 2; ++ai)
#pragma unroll
                        for (int m = 0; m < 4; ++m) {
                            const int s = (row0 + ai * 128 + m * 16) & (SEQ - 1);
                            const float xv = acc[ai][0][m][0][j] + bsv;
                            dp[s] = xv >= 0.f ? -log1pf(__expf(-xv)) : xv - log1pf(__expf(xv));
                        }
                }
            }
        }
    }
};

struct EpiRes {
    static constexpr bool PERM = false, AFTER_DRAIN = false;
    float w; float* out;
    __device__ __forceinline__ void operator()(const pg8::f32x4 (&acc)[2][2][4][2], const pg8::Unit& u, int wr, int wc, int fr, int fq) const {
        const int row0 = u.pm * 256 + wr * 64 + fr, col0 = u.pn * 256 + wc * 32 + 4 * fq;
#pragma unroll
        for (int ai = 0; ai < 2; ++ai)
#pragma unroll
            for (int m = 0; m < 4; ++m) {
                float* rp = out + (size_t)(row0 + ai * 128 + m * 16) * DM + col0;
#pragma unroll
                for (int bj = 0; bj < 2; ++bj)
#pragma unroll
                    for (int n = 0; n < 2; ++n) { f32x4* p = (f32x4*)(rp + bj * 128 + 16 * n); const f32x4 v = *p; *p = v * ALPHA + acc[ai][bj][m][n] * w; }
                asm volatile("" ::: "memory");
            }
    }
};
__device__ __forceinline__ void tr_item(const float* W, int K, int N, bf16* WT, int dst_row0, const float* kscale, LAS float* scr, int k0, int n0, int lane) {
    const int nn = n0 + (lane & 31);
#pragma unroll 8
    for (int i = 0; i < 32; ++i) {
        const int kk = 2 * i + (lane >> 5);
        float v = nn < N ? W[(size_t)(k0 + kk) * N + nn] : 0.f;
        if (kscale) v *= kscale[k0 + kk];
        scr[kk * 33 + (lane & 31)] = v;
    }
    asm volatile("s_waitcnt lgkmcnt(0)" ::: "memory");
    const int c = lane & 7;
#pragma unroll
    for (int j = 0; j < 4; ++j) {
        const int n = (lane >> 3) + 8 * j; const LAS float* s = scr + (8 * c) * 33 + n;
        u32x4 o; o.x = pk2(s[0 * 33], s[1 * 33]); o.y = pk2(s[2 * 33], s[3 * 33]); o.z = pk2(s[4 * 33], s[5 * 33]); o.w = pk2(s[6 * 33], s[7 * 33]);
        *(u32x4*)(WT + (size_t)(dst_row0 + n) * K + k0 + 8 * c) = o;
    }
    asm volatile("s_waitcnt lgkmcnt(0)" ::: "memory");
}
struct MatD { const float* W; int K, N; bf16* WT; int kind; const float* ks; };
__device__ __forceinline__ MatD get_mat(const Args& a, int L, int mi) {
    MatD d; d.ks = nullptr; d.kind = 0;
    const int kind = L % 3, j = L / 3;
    unsigned char* ws = a.ws; asm volatile("" : "+s"(ws));
    if (mi < 6) {
        const int h = mi / 3, t = mi % 3; const size_t lo = (size_t)(L * 2 + h) * DM * DFF;
        if (t == 0) { d.W = a.wg + lo; d.K = DM; d.N = DFF; d.WT = (bf16*)(ws + (h ? WS_WGU1 : WS_WGU0)); d.kind = 1; }
        else if (t == 1) { d.W = a.wu + lo; d.K = DM; d.N = DFF; d.WT = (bf16*)(ws + (h ? WS_WGU1 : WS_WGU0)); d.kind = 2; }
        else { d.W = a.wd + lo; d.K = DFF; d.N = DM; d.WT = (bf16*)(ws + (h ? WS_WD1 : WS_WD0)); }
    } else if (mi == 6) {
        d.K = DM; d.WT = (bf16*)(ws + WS_WIN);
        if (kind == 0) { d.W = a.ssm_win + (size_t)j * DM * 5152; d.N = 5152; }
        else if (kind == 1) { d.W = a.fox_win + (size_t)j * DM * 3088; d.N = 3088; }
        else { d.W = a.moba_win + (size_t)j * DM * 3072; d.N = 3072; }
    } else {
        d.N = DM; d.WT = (bf16*)(ws + WS_WOUT);
        if (kind == 0) { d.W = a.ssm_wout + (size_t)j * 2048 * DM; d.K = 2048; d.ks = a.ssm_nw + j * 2048; }
        else if (kind == 1) { d.W = a.fox_wout + (size_t)j * DM * DM; d.K = DM; }
        else { d.W = a.moba_wout + (size_t)j * DM * DM; d.K = DM; }
    }
    return d;
}
__device__ __forceinline__ void convert_layer(const Args& a, int L, LAS unsigned char* lds, int gw, int NGW, int wid, int lane) {
    LAS float* scr = (LAS float*)(lds + wid * 8448);
    for (int mi = 0; mi < 8; ++mi) {
        const MatD d = get_mat(a, L, mi);
        const int nnb = (d.N + 31) / 32, cnt = (d.K / 64) * nnb;
        for (int it = gw; it < cnt; it += NGW) {
            const int kb = it / nnb, nb = it % nnb, n0 = nb * 32;
            const int dr = d.kind == 0 ? n0 : ((n0 >> 7) * 256 + (n0 & 127) + (d.kind == 2 ? 128 : 0));
            tr_item(d.W, d.K, d.N, d.WT, dr, d.ks, scr, kb * 64, n0, lane);
        }
    }
}

__device__ __forceinline__ void ln_pass(float* out, bf16* h16, const float* g, const float* bta, int gw, int NGW, int lane) {
    for (int row = gw; row < MTOK; row += NGW) {
        f32x4* xr = (f32x4*)(out + (size_t)row * DM) + lane;
        f32x4 v[4]; float s = 0.f;
#pragma unroll
        for (int j = 0; j < 4; ++j) { v[j] = xr[64 * j]; s += (v[j][0] + v[j][1]) + (v[j][2] + v[j][3]); }
        const float mean = wave_sum(s) * (1.f / DM); float s2 = 0.f;
#pragma unroll
        for (int j = 0; j < 4; ++j) { v[j] = v[j] - mean; s2 += (v[j][0] * v[j][0] + v[j][1] * v[j][1]) + (v[j][2] * v[j][2] + v[j][3] * v[j][3]); }
        const float rstd = 1.f / sqrtf(wave_sum(s2) * (1.f / DM) + LN_EPS);
        u32x2* o8 = (u32x2*)(h16 + (size_t)row * DM) + lane;
#pragma unroll
        for (int j = 0; j < 4; ++j) {
            const f32x4 gg = *((const f32x4*)g + lane + 64 * j), bb = *((const f32x4*)bta + lane + 64 * j);
            const f32x4 y = v[j] * rstd * gg + bb;
            xr[64 * j] = y;
            u32x2 p; p.x = pk2(y[0], y[1]); p.y = pk2(y[2], y[3]); o8[64 * j] = p;
        }
    }
}

__device__ __forceinline__ void conv_phase(const Args& a, int jj, int bid, int G, int tid, int wid, int lane) {
    unsigned char* ws = a.ws; asm volatile("" : "+s"(ws));
    const bf16* XBC = (const bf16*)(ws + WS_XBC);
    bf16* XT = (bf16*)(ws + WS_XT); bf16* BM = (bf16*)(ws + WS_BM); bf16* CMm = (bf16*)(ws + WS_CM); bf16* BT = (bf16*)(ws + WS_BT);
    const float* cw = a.ssm_cw + (size_t)jj * 4 * 3072; const float* cb = a.ssm_cb + (size_t)jj * 3072;
    for (int u = bid; u < 1536; u += G) {
        const int slab = u % 6, tt = (u / 6) % 128, b = u / 768;
        const int cp = tid & 255, tg = tid >> 8, ch = slab * 512 + 2 * cp, t0 = tt * 64 + tg * 32;
        float w0[4], w1[4];
#pragma unroll
        for (int k = 0; k < 4; ++k) { w0[k] = cw[k * 3072 + ch]; w1[k] = cw[k * 3072 + ch + 1]; }
        const float b0 = cb[ch], b1 = cb[ch + 1];
        const unsigned* src = (const unsigned*)(XBC + (size_t)(b * SEQ) * 3072 + ch);
        float xa[3], xb[3];
#pragma unroll
        for (int k = 0; k < 3; ++k) { const int t = t0 - 3 + k; unsigned v = 0u; if (t >= 0) v = src[(size_t)t * 1536]; xa[k] = bflo(v); xb[k] = bfhi(v); }
#pragma unroll
        for (int i8 = 0; i8 < 4; ++i8) {
            unsigned oa[4], ob[4];
#pragma unroll
            for (int i = 0; i < 8; ++i) {
                const int t = t0 + i8 * 8 + i;
                const unsigned v = src[(size_t)t * 1536];
                const float ca = bflo(v), cbv = bfhi(v);
                float ya = b0 + w0[0] * xa[0] + w0[1] * xa[1] + w0[2] * xa[2] + w0[3] * ca;
                float yb = b1 + w1[0] * xb[0] + w1[1] * xb[1] + w1[2] * xb[2] + w1[3] * cbv;
                xa[0] = xa[1]; xa[1] = xa[2]; xa[2] = ca; xb[0] = xb[1]; xb[1] = xb[2]; xb[2] = cbv;
                ya = siluf(ya); yb = siluf(yb);
                const unsigned pr = pk2(ya, yb);
                if (slab == 4) *(unsigned*)(BM + (size_t)(b * SEQ + t) * 512 + (ch - 2048)) = pr;
                if (slab == 5) *(unsigned*)(CMm + (size_t)(b * SEQ + t) * 512 + (ch - 2560)) = pr;
                if (i & 1) { oa[i >> 1] = (oa[i >> 1] & 0xffffu) | (pr << 16); ob[i >> 1] = (ob[i >> 1] & 0xffffu) | (pr & 0xffff0000u); }
                else { oa[i >> 1] = pr & 0xffffu; ob[i >> 1] = pr >> 16; }
            }
            const int ts = t0 + i8 * 8;
            if (slab < 4) {
                bf16* d = XT + (size_t)ch * SEQ + (size_t)b * 2048 * SEQ + ts;
                *(u32x4*)d = (u32x4){oa[0], oa[1], oa[2], oa[3]};
                *(u32x4*)(d + SEQ) = (u32x4){ob[0], ob[1], ob[2], ob[3]};
            } else if (slab == 4) {
                bf16* d = BT + (size_t)(b * 512 + (ch - 2048)) * SEQ + ts;
                *(u32x4*)d = (u32x4){oa[0], oa[1], oa[2], oa[3]};
                *(u32x4*)(d + SEQ) = (u32x4){ob[0], ob[1], ob[2], ob[3]};
            }
        }
    }
    const float* DT = (const float*)(ws + WS_DT); float* ACS = (float*)(ws + WS_ACS);
    for (int seg = bid * 8 + wid; seg < 2048; seg += G * 8) {
        const int b = seg >> 10, h = (seg >> 5) & 31, c = seg & 31;
        const float A = -__expf(a.ssm_alog[jj * 32 + h]);
        const size_t off = (size_t)(b * 32 + h) * SEQ + c * 256 + 4 * lane;
        f32x4 d = *(const f32x4*)(DT + off);
        f32x4 p; p[0] = d[0] * A; p[1] = p[0] + d[1] * A; p[2] = p[1] + d[2] * A; p[3] = p[2] + d[3] * A;
        float tot = p[3];
#pragma unroll
        for (int o = 1; o < 64; o <<= 1) { const float t = __shfl_up(tot, o); if (lane >= o) tot += t; }
        const float ex = tot - p[3];
        *(f32x4*)(ACS + off) = p + ex;
    }
}

__device__ __forceinline__ void ssd_diag_phase(const Args& a, int jj, LAS unsigned char* lds, int bid, int G, int tid, int wid, int lane) {
    unsigned char* ws = a.ws; asm volatile("" : "+s"(ws));
    const bf16* BM = (const bf16*)(ws + WS_BM); const bf16* CMm = (const bf16*)(ws + WS_CM); const bf16* XT = (const bf16*)(ws + WS_XT); const bf16* BT = (const bf16*)(ws + WS_BT);
    const float* DT = (const float*)(ws + WS_DT); const float* ACS = (const float*)(ws + WS_ACS);
    float* ST = (float*)(ws + WS_ST); unsigned* YD = (unsigned*)(ws + WS_YD);
    constexpr int L_BM = 0, L_XT = 69632, L_ACS = 103424, L_DT = 104448, L_WG = 105472;
    const int r32 = lane & 31, hi = lane >> 5;
    for (int u = bid; u < 2048; u += G) {
        const int b = u >> 10, c = (u >> 5) & 31, h = u & 31, g = h >> 3;
        __syncthreads();
#pragma unroll
        for (int k = 0; k < 8; ++k) {
            const int idx = tid + 512 * k, row = idx >> 4, pc = idx & 15;
            const u32x4 v = *(const u32x4*)(BM + (size_t)(b * SEQ + c * 256 + row) * 512 + g * 128 + pc * 8);
            *(LAS u32x4*)(lds + L_BM + row * 272 + pc * 16) = v;
        }
#pragma unroll
        for (int k = 0; k < 4; ++k) {
            const int idx = tid + 512 * k, row = idx >> 5, pc = idx & 31;
            const u32x4 v = *(const u32x4*)(XT + (size_t)((b * 32 + h) * 64 + row) * SEQ + c * 256 + pc * 8);
            *(LAS u32x4*)(lds + L_XT + row * 528 + pc * 16) = v;
        }
        if (tid < 256) {
            const size_t o = (size_t)(b * 32 + h) * SEQ + c * 256;
            const float ac = ACS[o + tid], dtv = DT[o + tid], al = ACS[o + 255];
            *(LAS float*)(lds + L_ACS + tid * 4) = ac * LOG2E;
            *(LAS float*)(lds + L_DT + tid * 4) = dtv;
            *(LAS float*)(lds + L_WG + tid * 4) = dtv * __expf(al - ac);
        }
        __syncthreads();
        const float Dh = a.ssm_d[jj * 32 + h];
        const int l = 32 * wid + r32;
        bf16x8 cf[8];
#pragma unroll
        for (int ks = 0; ks < 8; ++ks) cf[ks] = *(const bf16x8*)(CMm + (size_t)(b * SEQ + c * 256 + l) * 512 + g * 128 + 16 * ks + 8 * hi);
        const float acl = *(LAS float*)(lds + L_ACS + l * 4);
        f32x16 o[2]; o[0] = f32x16{}; o[1] = f32x16{};
        for (int j = 0; j <= wid; ++j) {
            f32x16 gt = f32x16{};
#pragma unroll
            for (int ks = 0; ks < 8; ++ks) {
                const bf16x8 bfr = *(LAS bf16x8*)(lds + L_BM + (32 * j + r32) * 272 + (16 * ks + 8 * hi) * 2);
                gt = __builtin_amdgcn_mfma_f32_32x32x16_bf16(bfr, cf[ks], gt, 0, 0, 0);
            }
            unsigned pw[8];
#pragma unroll
            for (int i = 0; i < 4; ++i) {
                const int sb = 32 * j + 8 * i + 4 * hi;
                const f32x4 a4 = *(LAS f32x4*)(lds + L_ACS + sb * 4), d4 = *(LAS f32x4*)(lds + L_DT + sb * 4);
                float pv[4];
#pragma unroll
                for (int q = 0; q < 4; ++q) {
                    float val = gt[4 * i + q] * __builtin_amdgcn_exp2f(acl - a4[q]) * d4[q];
                    if (j == wid) { const int s = sb + q; val = (s <= l) ? val : 0.f; if (s == l) val += Dh; }
                    pv[q] = val;
                }
                pw[2 * i] = pk2(pv[0], pv[1]); pw[2 * i + 1] = pk2(pv[2], pv[3]);
            }
#pragma unroll
            for (int ks = 0; ks < 2; ++ks) {
                const bf16x8 pf = __builtin_bit_cast(bf16x8, (u32x4){pw[4 * ks], pw[4 * ks + 1], pw[4 * ks + 2], pw[4 * ks + 3]});
#pragma unroll
                for (int d0 = 0; d0 < 2; ++d0) {
                    const LAS unsigned char* xp = lds + L_XT + (32 * d0 + r32) * 528 + (32 * j + 16 * ks + 4 * hi) * 2;
                    const u32x2 xa = *(const LAS u32x2*)xp, xb = *(const LAS u32x2*)(xp + 16);
                    const bf16x8 xf = __builtin_bit_cast(bf16x8, (u32x4){xa.x, xa.y, xb.x, xb.y});
                    o[d0] = __builtin_amdgcn_mfma_f32_32x32x16_bf16(xf, pf, o[d0], 0, 0, 0);
                }
            }
        }
        {
            unsigned* yd = YD + ((size_t)u * 8 + wid) * 1024 + lane;
#pragma unroll
            for (int d0 = 0; d0 < 2; ++d0)
#pragma unroll
                for (int r = 0; r < 16; r += 2) yd[(d0 * 8 + (r >> 1)) * 64] = pk2(o[d0][r], o[d0][r + 1]);
        }
        {
            const int pt = wid & 1, nt = wid >> 1;
            f32x16 st = f32x16{};
            const bf16* bp = BT + (size_t)((b * 4 + g) * 128 + 32 * nt + r32) * SEQ + c * 256 + 8 * hi;
#pragma unroll 4
            for (int ks = 0; ks < 16; ++ks) {
                const u32x4 xr = *(LAS u32x4*)(lds + L_XT + (32 * pt + r32) * 528 + (16 * ks + 8 * hi) * 2);
                const f32x4 wa = *(LAS f32x4*)(lds + L_WG + (16 * ks + 8 * hi) * 4), wb = *(LAS f32x4*)(lds + L_WG + (16 * ks + 8 * hi + 4) * 4);
                u32x4 xs;
                xs.x = pk2(bflo(xr.x) * wa[0], bfhi(xr.x) * wa[1]); xs.y = pk2(bflo(xr.y) * wa[2], bfhi(xr.y) * wa[3]);
                xs.z = pk2(bflo(xr.z) * wb[0], bfhi(xr.z) * wb[1]); xs.w = pk2(bflo(xr.w) * wb[2], bfhi(xr.w) * wb[3]);
                const bf16x8 bfr = *(const bf16x8*)(bp + 16 * ks);
                st = __builtin_amdgcn_mfma_f32_32x32x16_bf16(__builtin_bit_cast(bf16x8, xs), bfr, st, 0, 0, 0);
            }
            float* sp = ST + (size_t)u * 8192 + 32 * nt + r32;
#pragma unroll
            for (int r = 0; r < 16; ++r) sp[(32 * pt + crow(r, hi)) * 128] = st[r];
        }
    }
}

__device__ __forceinline__ void ssd_scan_phase(const Args& a, int bid, int G, int tid) {
    unsigned char* ws = a.ws; asm volatile("" : "+s"(ws));
    const float* ST = (const float*)(ws + WS_ST); bf16* SIN = (bf16*)(ws + WS_SIN); const float* ACS = (const float*)(ws + WS_ACS);
    for (int gt = bid * 512 + tid; gt < 131072; gt += G * 512) {
        const int b = gt >> 16, h = (gt >> 11) & 31, q4 = gt & 2047;
        f32x4 v[32];
#pragma unroll
        for (int c = 0; c < 32; ++c) v[c] = *(const f32x4*)(ST + ((size_t)((b * 32 + c) * 32 + h)) * 8192 + q4 * 4);
        f32x4 run = (f32x4){0.f, 0.f, 0.f, 0.f};
#pragma unroll
        for (int c = 0; c < 32; ++c) {
            u32x2 p; p.x = pk2(run[0], run[1]); p.y = pk2(run[2], run[3]);
            *(u32x2*)(SIN + ((size_t)((b * 32 + c) * 32 + h)) * 8192 + q4 * 4) = p;
            const float dec = __expf(ACS[(size_t)(b * 32 + h) * SEQ + c * 256 + 255]);
            run = run * dec + v[c];
        }
    }
}

__device__ __forceinline__ void ssd_out_phase(const Args& a, int bid, int G, int tid, int wid, int lane) {
    unsigned char* ws = a.ws; asm volatile("" : "+s"(ws));
    const bf16* CMm = (const bf16*)(ws + WS_CM); const bf16* SIN = (const bf16*)(ws + WS_SIN); const bf16* Z = (const bf16*)(ws + WS_Z);
    const unsigned* YD = (const unsigned*)(ws + WS_YD); const float* ACS = (const float*)(ws + WS_ACS); bf16* Y = (bf16*)(ws + WS_Y);
    const int r32 = lane & 31, hi = lane >> 5;
    for (int u = bid; u < 256; u += G) {
        const int b = u >> 7, c = (u >> 2) & 31, g = u & 3;
        const int l = 32 * wid + r32; const size_t row = (size_t)b * SEQ + c * 256 + l;
        bf16x8 cf[8];
#pragma unroll
        for (int ks = 0; ks < 8; ++ks) cf[ks] = *(const bf16x8*)(CMm + row * 512 + g * 128 + 16 * ks + 8 * hi);
        float ssq = 0.f;
        for (int rr = 0; rr < 8; ++rr) {
            const int h = 8 * g + rr; const int uu = (b * 32 + c) * 32 + h;
            const float dec = __expf(ACS[(size_t)(b * 32 + h) * SEQ + c * 256 + l]);
            f32x16 o[2]; o[0] = f32x16{}; o[1] = f32x16{};
#pragma unroll
            for (int d0 = 0; d0 < 2; ++d0)
#pragma unroll
                for (int ks = 0; ks < 8; ++ks) {
                    const bf16x8 sa = *(const bf16x8*)(SIN + (size_t)uu * 8192 + (32 * d0 + r32) * 128 + 16 * ks + 8 * hi);
                    o[d0] = __builtin_amdgcn_mfma_f32_32x32x16_bf16(sa, cf[ks], o[d0], 0, 0, 0);
                }
            const unsigned* yd = YD + ((size_t)uu * 8 + wid) * 1024 + lane;
#pragma unroll
            for (int d0 = 0; d0 < 2; ++d0)
#pragma unroll
                for (int i = 0; i < 4; ++i) {
                    const int col = 64 * h + 32 * d0 + 8 * i + 4 * hi;
                    const u32x2 z2 = *(const u32x2*)(Z + row * 2048 + col);
                    const unsigned y01 = yd[(d0 * 8 + 2 * i) * 64], y23 = yd[(d0 * 8 + 2 * i + 1) * 64];
                    const float y0 = (o[d0][4 * i] * dec + bflo(y01)) * siluf(bflo(z2.x));
                    const float y1 = (o[d0][4 * i + 1] * dec + bfhi(y01)) * siluf(bfhi(z2.x));
                    const float y2 = (o[d0][4 * i + 2] * dec + bflo(y23)) * siluf(bflo(z2.y));
                    const float y3 = (o[d0][4 * i + 3] * dec + bfhi(y23)) * siluf(bfhi(z2.y));
                    ssq += (y0 * y0 + y1 * y1) + (y2 * y2 + y3 * y3);
                    u32x2 p; p.x = pk2(y0, y1); p.y = pk2(y2, y3);
                    *(u32x2*)(Y + row * 2048 + col) = p;
                }
        }
        ssq += __shfl_xor(ssq, 32);
        const float rstd = 1.f / sqrtf(ssq * (1.f / 512.f) + LN_EPS);
        asm volatile("s_waitcnt vmcnt(0)" ::: "memory");
        for (int rr = 0; rr < 8; ++rr) {
#pragma unroll
            for (int d0 = 0; d0 < 2; ++d0)
#pragma unroll
                for (int i = 0; i < 4; ++i) {
                    const int col = 64 * (8 * g + rr) + 32 * d0 + 8 * i + 4 * hi;
                    u32x2* yp = (u32x2*)(Y + row * 2048 + col);
                    const u32x2 v = *yp; u32x2 p;
                    p.x = pk2(bflo(v.x) * rstd, bfhi(v.x) * rstd); p.y = pk2(bflo(v.y) * rstd, bfhi(v.y) * rstd);
                    *yp = p;
                }
        }
    }
}

__device__ __forceinline__ void fox_cum_phase(const Args& a, LAS unsigned char* lds, int bid, int G, int tid, int wid, int lane) {
    unsigned char* ws = a.ws; asm volatile("" : "+s"(ws));
    const float* LF = (const float*)(ws + WS_LF); float* CUM = (float*)(ws + WS_CUM);
    LAS float* wt = (LAS float*)lds;
    for (int sq = bid; sq < 32; sq += G) {
        __syncthreads();
        const float* src = LF + (size_t)sq * SEQ + tid * 16;
        f32x4 v[4]; float run = 0.f;
#pragma unroll
        for (int k = 0; k < 4; ++k) { v[k] = *(const f32x4*)(src + 4 * k);
#pragma unroll
            for (int q = 0; q < 4; ++q) { run += v[k][q]; v[k][q] = run; } }
        float tot = run;
#pragma unroll
        for (int o = 1; o < 64; o <<= 1) { const float t = __shfl_up(tot, o); if (lane >= o) tot += t; }
        if (lane == 63) wt[wid] = tot;
        __syncthreads();
        float base = tot - run;
        for (int w = 0; w < wid; ++w) base += wt[w];
        float* dst = CUM + (size_t)sq * SEQ + tid * 16;
#pragma unroll
        for (int k = 0; k < 4; ++k) *(f32x4*)(dst + 4 * k) = (v[k] + base) * LOG2E;
    }
}
__device__ __forceinline__ void moba_kmean_phase(const Args& a, int bid, int G, int tid) {
    unsigned char* ws = a.ws; asm volatile("" : "+s"(ws));
    const bf16* K = (const bf16*)(ws + WS_K); float* KM = (float*)(ws + WS_KM);
    for (int u = bid; u < 64; u += G) {
        const int b = u >> 5, j = u & 31;
        const unsigned* src = (const unsigned*)(K + (size_t)(b * SEQ + j * 256) * DM) + tid;
        float s0 = 0.f, s1 = 0.f;
#pragma unroll 8
        for (int r = 0; r < 256; ++r) { const unsigned v = src[(size_t)r * 512]; s0 += bflo(v); s1 += bfhi(v); }
        const int col = 2 * tid, h = col >> 6, d = col & 63;
        float* dst = KM + ((size_t)((b * 16 + h) * 32 + j)) * 64 + d;
        dst[0] = s0 * (1.f / 256.f); dst[1] = s1 * (1.f / 256.f);
    }
}

template <bool FOX>
__device__ __forceinline__ void attn_phase(const Args& a, LAS unsigned char* lds, int bid, int G, int tid, int wid, int lane) {
    unsigned char* ws = a.ws; asm volatile("" : "+s"(ws));
    const bf16* Q = (const bf16*)(ws + WS_Q); const bf16* K = (const bf16*)(ws + WS_K); const bf16* VT = (const bf16*)(ws + WS_VT);
    const float* CUM = (const float*)(ws + WS_CUM); const float* KM = (const float*)(ws + WS_KM); bf16* O = (bf16*)(ws + WS_O);
    constexpr int L_K = 0, L_V = 18432, L_CK = 36864, L_KM = 37376, L_UM = 45568, L_BL = 45584;
    const int r32 = lane & 31, hi = lane >> 5;
    const float NEG = -INFINITY;
    for (int ui = 0; ui < 4; ++ui) {
        const int v = bid + 0 * G;
        const int bh = v >> 3, sx = v & 7;
        const int qb = (ui == 0) ? sx : (ui == 1) ? 15 - sx : (ui == 2) ? 16 + sx : 31 - sx;
        const int b = bh >> 4, h = bh & 15;
        const int q0 = qb * 256, qw = q0 + wid * 32, q = qw + r32;
        __syncthreads();
        bf16x8 qf[4];
#pragma unroll
        for (int d0 = 0; d0 < 4; ++d0) qf[d0] = *(const bf16x8*)(Q + (size_t)(b * SEQ + q) * DM + h * 64 + 16 * d0 + 8 * hi);
        unsigned selmask = 0xffffffffu;
        if (!FOX) {
            *(LAS f32x4*)(lds + L_KM + tid * 16) = *(const f32x4*)(KM + (size_t)bh * 2048 + tid * 4);
            if (tid == 0) *(LAS unsigned*)(lds + L_UM) = 0u;
            __syncthreads();
            float qv[32];
#pragma unroll
            for (int d0 = 0; d0 < 4; ++d0) { const u32x4 t = __builtin_bit_cast(u32x4, qf[d0]);
                qv[d0 * 8 + 0] = bflo(t.x); qv[d0 * 8 + 1] = bfhi(t.x); qv[d0 * 8 + 2] = bflo(t.y); qv[d0 * 8 + 3] = bfhi(t.y);
                qv[d0 * 8 + 4] = bflo(t.z); qv[d0 * 8 + 5] = bfhi(t.z); qv[d0 * 8 + 6] = bflo(t.w); qv[d0 * 8 + 7] = bfhi(t.w); }
            float v1 = NEG, v2 = NEG, v3 = NEG; int i1 = -1, i2 = -1, i3 = -1;
            for (int j = 0; j < qb; ++j) {
                float part = 0.f;
#pragma unroll
                for (int d0 = 0; d0 < 4; ++d0) {
                    const f32x4 k0 = *(LAS f32x4*)(lds + L_KM + (j * 64 + 16 * d0 + 8 * hi) * 4), k1 = *(LAS f32x4*)(lds + L_KM + (j * 64 + 16 * d0 + 8 * hi + 4) * 4);
                    part += qv[d0 * 8 + 0] * k0[0] + qv[d0 * 8 + 1] * k0[1] + qv[d0 * 8 + 2] * k0[2] + qv[d0 * 8 + 3] * k0[3]
                          + qv[d0 * 8 + 4] * k1[0] + qv[d0 * 8 + 5] * k1[1] + qv[d0 * 8 + 6] * k1[2] + qv[d0 * 8 + 7] * k1[3];
                }
                const float gsc = part + __shfl_xor(part, 32);
                if (gsc > v1) { v3 = v2; i3 = i2; v2 = v1; i2 = i1; v1 = gsc; i1 = j; }
                else if (gsc > v2) { v3 = v2; i3 = i2; v2 = gsc; i2 = j; }
                else if (gsc > v3) { v3 = gsc; i3 = j; }
            }
            selmask = (i1 >= 0 ? (1u << i1) : 0u) | (i2 >= 0 ? (1u << i2) : 0u) | (i3 >= 0 ? (1u << i3) : 0u);
            __hip_atomic_fetch_or((LAS unsigned*)(lds + L_UM), selmask, __ATOMIC_RELAXED, __HIP_MEMORY_SCOPE_WORKGROUP);
            __syncthreads();
        }
        if (tid == 0) {
            unsigned um = FOX ? ((qb == 0) ? 0u : (0xffffffffu >> (32 - qb))) : *(LAS unsigned*)(lds + L_UM);
            um |= (1u << qb);
            int n = 0;
            for (int j = 0; j <= qb; ++j) if ((um >> j) & 1u) { *(LAS int*)(lds + L_BL + 4 + 4 * n) = j; ++n; }
            *(LAS int*)(lds + L_BL) = n;
        }
        __syncthreads();
        const int NTT = 4 * *(LAS int*)(lds + L_BL);
        float cq = 0.f;
        if (FOX) cq = CUM[(size_t)bh * SEQ + q];
        float m = NEG, lsum = 0.f;
        f32x16 o[2]; o[0] = f32x16{}; o[1] = f32x16{};
        const int srow = tid >> 3, spc = tid & 7;
        const bf16* kg = K + (size_t)(b * SEQ + srow) * DM + h * 64 + spc * 8;
        const bf16* vg = VT + (size_t)(bh * 64 + srow) * SEQ + spc * 8;
        const float* cg_ = CUM + (size_t)bh * SEQ + (tid & 63);
        u32x4 kreg, vreg; float creg = 0.f;
        {
            const int blk = *(LAS int*)(lds + L_BL + 4); const int k0 = blk * 256;
            kreg = *(const u32x4*)(kg + (size_t)k0 * DM); vreg = *(const u32x4*)(vg + k0);
            if (FOX && tid < 64) creg = cg_[k0];
            *(LAS u32x4*)(lds + L_K + srow * 144 + spc * 16) = kreg; *(LAS u32x4*)(lds + L_V + srow * 144 + spc * 16) = vreg;
            if (FOX && tid < 64) *(LAS float*)(lds + L_CK + tid * 4) = creg;
        }
        __syncthreads();
        for (int ti = 0; ti < NTT; ++ti) {
            const int cur = ti & 1;
            const int blk = *(LAS int*)(lds + L_BL + 4 + 4 * (ti >> 2)); const int k0 = blk * 256 + (ti & 3) * 64;
            const bool more = ti + 1 < NTT;
            if (more) {
                const int nblk = *(LAS int*)(lds + L_BL + 4 + 4 * ((ti + 1) >> 2)); const int nk0 = nblk * 256 + ((ti + 1) & 3) * 64;
                kreg = *(const u32x4*)(kg + (size_t)nk0 * DM); vreg = *(const u32x4*)(vg + nk0);
                if (FOX && tid < 64) creg = cg_[nk0];
            }
            const bool isown = (blk == qb);
            bool active;
            if (isown) active = (k0 <= qw + 31);
            else active = FOX ? true : (__ballot((selmask >> blk) & 1u) != 0ull);
            if (active) {
                const LAS unsigned char* kb = lds + L_K + cur * 9216; const LAS unsigned char* vb = lds + L_V + cur * 9216;
                f32x16 s0 = f32x16{}, s1 = f32x16{};
#pragma unroll
                for (int d0 = 0; d0 < 4; ++d0) {
                    const bf16x8 kf0 = *(const LAS bf16x8*)(kb + r32 * 144 + (16 * d0 + 8 * hi) * 2);
                    const bf16x8 kf1 = *(const LAS bf16x8*)(kb + (32 + r32) * 144 + (16 * d0 + 8 * hi) * 2);
                    s0 = __builtin_amdgcn_mfma_f32_32x32x16_bf16(kf0, qf[d0], s0, 0, 0, 0);
                    s1 = __builtin_amdgcn_mfma_f32_32x32x16_bf16(kf1, qf[d0], s1, 0, 0, 0);
                }
                if (FOX) {
                    const LAS unsigned char* cb = lds + L_CK + cur * 256;
#pragma unroll
                    for (int i = 0; i < 4; ++i) {
                        const f32x4 c0 = *(const LAS f32x4*)(cb + (8 * i + 4 * hi) * 4), c1 = *(const LAS f32x4*)(cb + (32 + 8 * i + 4 * hi) * 4);
#pragma unroll
                        for (int t = 0; t < 4; ++t) { s0[4 * i + t] += cq - c0[t]; s1[4 * i + t] += cq - c1[t]; }
                    }
                }
                if (isown) {
#pragma unroll
                    for (int r = 0; r < 16; ++r) { const int key = k0 + crow(r, hi); if (key > q) s0[r] = NEG; if (key + 32 > q) s1[r] = NEG; }
                } else if (!FOX) {
                    if (!((selmask >> blk) & 1u)) {
#pragma unroll
                        for (int r = 0; r < 16; ++r) { s0[r] = NEG; s1[r] = NEG; }
                    }
                }
                float mx = fmaxf(s0[0], s1[0]);
#pragma unroll
                for (int r = 1; r < 16; ++r) mx = fmaxf(mx, fmaxf(s0[r], s1[r]));
                mx = fmaxf(mx, __shfl_xor(mx, 32));
                const float mnew = fmaxf(m, mx);
                const float msafe = (mnew == NEG) ? 0.f : mnew;
                const float f = __builtin_amdgcn_exp2f(m - msafe);
                m = mnew;
                float ps = 0.f;
#pragma unroll
                for (int r = 0; r < 16; ++r) { s0[r] = __builtin_amdgcn_exp2f(s0[r] - msafe); s1[r] = __builtin_amdgcn_exp2f(s1[r] - msafe); ps += s0[r] + s1[r]; }
                lsum = lsum * f + ps;
#pragma unroll
                for (int r = 0; r < 16; ++r) { o[0][r] *= f; o[1][r] *= f; }
#pragma unroll
                for (int kt = 0; kt < 2; ++kt)
#pragma unroll
                    for (int ks = 0; ks < 2; ++ks) {
                        u32x4 pw;
                        if (kt == 0) { pw.x = pk2(s0[8 * ks], s0[8 * ks + 1]); pw.y = pk2(s0[8 * ks + 2], s0[8 * ks + 3]); pw.z = pk2(s0[8 * ks + 4], s0[8 * ks + 5]); pw.w = pk2(s0[8 * ks + 6], s0[8 * ks + 7]); }
                        else { pw.x = pk2(s1[8 * ks], s1[8 * ks + 1]); pw.y = pk2(s1[8 * ks + 2], s1[8 * ks + 3]); pw.z = pk2(s1[8 * ks + 4], s1[8 * ks + 5]); pw.w = pk2(s1[8 * ks + 6], s1[8 * ks + 7]); }
                        const bf16x8 pf = __builtin_bit_cast(bf16x8, pw);
#pragma unroll
                        for (int d0 = 0; d0 < 2; ++d0) {
                            const LAS unsigned char* vp = vb + (32 * d0 + r32) * 144 + (32 * kt + 16 * ks + 4 * hi) * 2;
                            const u32x2 xa = *(const LAS u32x2*)vp, xb = *(const LAS u32x2*)(vp + 16);
                            const bf16x8 vf = __builtin_bit_cast(bf16x8, (u32x4){xa.x, xa.y, xb.x, xb.y});
                            o[d0] = __builtin_amdgcn_mfma_f32_32x32x16_bf16(vf, pf, o[d0], 0, 0, 0);
                        }
                    }
            }
            if (more) {
                const int nb = cur ^ 1;
                *(LAS u32x4*)(lds + L_K + nb * 9216 + srow * 144 + spc * 16) = kreg; *(LAS u32x4*)(lds + L_V + nb * 9216 + srow * 144 + spc * 16) = vreg;
                if (FOX && tid < 64) *(LAS float*)(lds + L_CK + nb * 256 + tid * 4) = creg;
            }
            __syncthreads();
        }
        lsum += __shfl_xor(lsum, 32);
        const float inv = 1.f / lsum;
        bf16* op = O + (size_t)(b * SEQ + q) * DM + h * 64;
#pragma unroll
        for (int d0 = 0; d0 < 2; ++d0)
#pragma unroll
            for (int i = 0; i < 4; ++i) {
                u32x2 p; p.x = pk2(o[d0][4 * i] * inv, o[d0][4 * i + 1] * inv); p.y = pk2(o[d0][4 * i + 2] * inv, o[d0][4 * i + 3] * inv);
                *(u32x2*)(op + 32 * d0 + 8 * i + 4 * hi) = p;
            }
    }
}

#define XB_TMO      128
#define XB_XCNT(j)  (256  + 64 * (j))
#define XB_XSUB(j)  (1280 + 64 * (j))
#define XB_XGEN(j)  (2304 + 64 * (j))
#define XB_TOP      3328
#define XB_TOPGEN   3392
#define XCD_BAR_WORDS 3456
#define XB_SPIN_CAP (1u << 18)

__device__ __forceinline__ unsigned xb_ld(unsigned* p)              { return __hip_atomic_load(p, __ATOMIC_RELAXED, __HIP_MEMORY_SCOPE_AGENT); }
__device__ __forceinline__ unsigned xb_add(unsigned* p, unsigned v) { return __hip_atomic_fetch_add(p, v, __ATOMIC_RELAXED, __HIP_MEMORY_SCOPE_AGENT); }
__device__ __forceinline__ unsigned xb_xcc_id() { return (unsigned)__builtin_amdgcn_s_getreg((3 << 11) | 20) & 0xFu; }
#define XB_SPIN(cond, bar) do { unsigned _sp = 0; while (cond) { __builtin_amdgcn_s_sleep(1); \
    if ((++_sp & 255u) == 0u) { if (xb_ld(&(bar)[XB_TMO])) break; if (_sp > XB_SPIN_CAP) { atomicAdd(&(bar)[XB_TMO], 1u); break; } } } } while (0)

struct XcdBarrier {
    unsigned* bar; unsigned x;
    volatile LAS unsigned* st;
};

__device__ __forceinline__ XcdBarrier xcd_barrier_post(unsigned* bar, volatile LAS unsigned* st) {
    XcdBarrier b; b.bar = bar; b.x = xb_xcc_id(); b.st = st;
    if (threadIdx.x == 0) (void)xb_add(&bar[XB_XCNT(b.x)], 1u);
    return b;
}
__device__ __forceinline__ void xcd_barrier_complete(unsigned* bar, unsigned x, unsigned& nloc, unsigned& nx) {
    const unsigned G = gridDim.x * gridDim.y * gridDim.z;
    unsigned sum, cnt, mine, sp = 0u;
    for (;;) {
        sum = 0u; cnt = 0u; mine = 0u;
#pragma unroll
        for (unsigned j = 0; j < 16; ++j) { const unsigned c = xb_ld(&bar[XB_XCNT(j)]); sum += c; cnt += (c > 0u) ? 1u : 0u; mine = (j == x) ? c : mine; }
        if (sum == G) break;
        __builtin_amdgcn_s_sleep(1);
        if ((++sp & 255u) == 0u) { if (xb_ld(&bar[XB_TMO])) break; if (sp > XB_SPIN_CAP) { atomicAdd(&bar[XB_TMO], 1u); break; } }
    }
    nloc = mine > 0u ? mine : 1u; nx = cnt > 0u ? cnt : 1u;
}

__device__ __forceinline__ void xcd_barrier(const XcdBarrier& b) {
    asm volatile("s_waitcnt vmcnt(0)" ::: "memory");
    __syncthreads();
    if (threadIdx.x == 0) {
        unsigned* bar = b.bar;
        __builtin_amdgcn_s_waitcnt(0);
        unsigned nloc = b.st[0], nx = b.st[1];
        if (nloc == 0u) { xcd_barrier_complete(bar, b.x, nloc, nx); b.st[0] = nloc; b.st[1] = nx; }
        const unsigned old = xb_add(&bar[XB_XSUB(b.x)], 1u);
        const unsigned gen = old / nloc;
        if (old + 1u == (gen + 1u) * nloc) {
            __builtin_amdgcn_fence(__ATOMIC_RELEASE, "agent");
            asm volatile("s_waitcnt vmcnt(0)" ::: "memory");
            const unsigned og = xb_add(&bar[XB_TOP], 1u);
            const unsigned tg = og / nx;
            if (og + 1u == (tg + 1u) * nx) xb_add(&bar[XB_TOPGEN], 1u);
            else XB_SPIN(xb_ld(&bar[XB_TOPGEN]) == tg, bar);
            __builtin_amdgcn_fence(__ATOMIC_ACQUIRE, "agent");
            xb_add(&bar[XB_XGEN(b.x)], 1u);
            asm volatile("s_waitcnt vmcnt(0)" ::: "memory");
        } else {
            XB_SPIN(xb_ld(&bar[XB_XGEN(b.x)]) == gen, bar);
            __builtin_amdgcn_fence(__ATOMIC_ACQUIRE, "agent");
            asm volatile("s_waitcnt vmcnt(0)" ::: "memory");
        }
    }
    __syncthreads();
}
enum { OP_INIT = 0, OP_FFN_UP, OP_FFN_DOWN, OP_LN, OP_SSM_IN, OP_CONV, OP_DIAG, OP_SCAN, OP_YOFF, OP_MIX_OUT, OP_ATT_IN, OP_AUX, OP_ATTN };
#ifdef PROBE_PH
constexpr int N_PHASES = 50;
#else
constexpr int N_PHASES = 49;
#endif

__global__ void __launch_bounds__(512, 2) fwd_mega(Args a_) {
    extern __shared__ __attribute__((aligned(16))) unsigned char smem[];
    LAS unsigned char* lds = (LAS unsigned char*)smem;
    cg::grid_group grid = cg::this_grid();
    const int tid0 = threadIdx.x;
    const int G0 = gridDim.x, bid0 = blockIdx.x;
    const int ph_lo = a_.ph_lo, ph_hi = a_.ph_hi;
    if (tid0 < 2) *(LAS unsigned*)(lds + L_XBST + 4 * tid0) = 0u;
    __syncthreads();
    XcdBarrier xbar; xbar.bar = (unsigned*)(a_.ws + WS_CTL); xbar.x = 0; xbar.st = nullptr;
    if (ph_hi - ph_lo > 1) xbar = xcd_barrier_post((unsigned*)(a_.ws + WS_CTL), (volatile LAS unsigned*)(lds + L_XBST));
    for (int ph = ph_lo; ph < ph_hi; ++ph) {
        int L = 0, op = OP_INIT, sub = 0;
        int phx = ph;
#ifdef PROBE_PH
        if (ph > PROBE_PH) phx = ph - 1;
#endif
        if (phx > 0) {
            int p = phx - 1;
            if (p >= 35) { L = 3; p -= 35; } else if (p >= 24) { L = 2; p -= 24; } else if (p >= 13) { L = 1; p -= 13; } else L = 0;
            const bool ssm = (L % 3) == 0;
            const int nmix = ssm ? 7 : 5;
            if (p < 3) { op = p == 0 ? OP_FFN_UP : p == 1 ? OP_FFN_DOWN : OP_LN; sub = 0; }
            else if (p < 3 + nmix) {
                const int q = p - 3;
                if (ssm) { op = q == 0 ? OP_SSM_IN : q == 1 ? OP_CONV : q == 2 ? OP_DIAG : q == 3 ? OP_SCAN : q == 4 ? OP_YOFF : q == 5 ? OP_MIX_OUT : OP_LN; }
                else { op = q == 0 ? OP_ATT_IN : q == 1 ? OP_AUX : q == 2 ? OP_ATTN : q == 3 ? OP_MIX_OUT : OP_LN; }
                sub = 1;
            } else { const int q = p - 3 - nmix; op = q == 0 ? OP_FFN_UP : q == 1 ? OP_FFN_DOWN : OP_LN; sub = (op == OP_LN) ? 2 : 1; }
        }
        const int kind = L % 3, jj = L / 3;
        {
        const __attribute__((address_space(4))) Args* ap = (const __attribute__((address_space(4))) Args*)__builtin_amdgcn_kernarg_segment_ptr();
        asm volatile("" : "+s"(ap));
#if defined(__HIP_DEVICE_COMPILE__)
        const Args a = *ap;
#else
        const Args a = a_;
#endif
        int tid = tid0, G = G0, bid = bid0; unsigned char* ws = a.ws;
        asm volatile("" : "+v"(tid)); asm volatile("" : "+s"(G), "+s"(bid), "+s"(ws));
        const int lane = tid & 63, wid = __builtin_amdgcn_readfirstlane(tid >> 6);
        const int gw = bid * 8 + wid, NGW = G * 8;
        const bool is_gemm = (op == OP_FFN_UP || op == OP_FFN_DOWN || op == OP_SSM_IN || op == OP_MIX_OUT || op == OP_ATT_IN);
        if (is_gemm) {
            pg8::Gemm g; Epi E; E.mode = 0; E.w = 1.f; E.out = a.out; E.ws = ws; E.bias = nullptr;
            g.M = MTOK; int kc = 0;
            if (op == OP_FFN_UP) { g.A = (const bf16*)(ws + WS_H16); g.Bt = (const bf16*)(ws + (sub ? WS_WGU1 : WS_WGU0)); g.N = 5632; E.mode = 0; }
            else if (op == OP_FFN_DOWN) { g.A = (const bf16*)(ws + WS_ACT); g.Bt = (const bf16*)(ws + (sub ? WS_WD1 : WS_WD0)); g.N = DM; kc = 1; E.mode = 1; E.w = 0.5f; }
            else if (op == OP_SSM_IN) { g.A = (const bf16*)(ws + WS_H16); g.Bt = (const bf16*)(ws + WS_WIN); g.N = 5376; E.mode = 2; E.bias = a.ssm_dtb + jj * 32; }
            else if (op == OP_ATT_IN) { g.A = (const bf16*)(ws + WS_H16); g.Bt = (const bf16*)(ws + WS_WIN); g.N = kind == 1 ? 3328 : 3072; E.mode = 3; E.bias = a.fox_bf + jj * 16; }
            else { g.Bt = (const bf16*)(ws + WS_WOUT); g.N = DM; E.mode = 1; E.w = 1.f;
                   if (kind == 0) { g.A = (const bf16*)(ws + WS_Y); kc = 2; } else { g.A = (const bf16*)(ws + WS_O); } }
            pg8::StaticOrder S; S.init(g.M, g.N, G, bid);
            if (kc == 0) { g.K = DM; pg8::gemm_phase<Epi, pg8::StaticOrder, true, true>(lds, g, S, E); }
            else { EpiRes E1; E1.w = E.w; E1.out = a.out; if (kc == 1) { g.K = DFF; pg8::gemm_phase<EpiRes, pg8::StaticOrder, true, true>(lds, g, S, E1); } else { g.K = 2048; pg8::gemm_phase<EpiRes, pg8::StaticOrder, true, true>(lds, g, S, E1); } }
        } else if (op == OP_INIT) {
            convert_layer(a, 0, lds, gw, NGW, wid, lane);
            const f32x4* xs = (const f32x4*)a.x; f32x4* od = (f32x4*)a.out; u32x2* hd = (u32x2*)(ws + WS_H16);
            for (int i = bid * 512 + tid; i < MTOK * DM / 4; i += G * 512) { const f32x4 v = xs[i]; od[i] = v; u32x2 p; p.x = pk2(v[0], v[1]); p.y = pk2(v[2], v[3]); hd[i] = p; }
        } else if (op == OP_LN) {
            ln_pass(a.out, (bf16*)(ws + WS_H16), a.lng + (size_t)(L * 3 + sub) * DM, a.lnb + (size_t)(L * 3 + sub) * DM, gw, NGW, lane);
            if (sub == 2 && L < 3) convert_layer(a, L + 1, lds, gw, NGW, wid, lane);
        } else if (op == OP_CONV) { conv_phase(a, jj, bid, G, tid, wid, lane);
        } else if (op == OP_DIAG) { ssd_diag_phase(a, jj, lds, bid, G, tid, wid, lane);
        } else if (op == OP_SCAN) { ssd_scan_phase(a, bid, G, tid);
        } else if (op == OP_YOFF) { ssd_out_phase(a, bid, G, tid, wid, lane);
        } else if (op == OP_AUX) { if (kind == 1) fox_cum_phase(a, lds, bid, G, tid, wid, lane); else moba_kmean_phase(a, bid, G, tid);
        } else if (op == OP_ATTN) { if (kind == 1) attn_phase<true>(a, lds, bid, G, tid, wid, lane); else attn_phase<false>(a, lds, bid, G, tid, wid, lane); }
        }
        if (ph + 1 < ph_hi) { if (ph == ph_lo) grid.sync(); else xcd_barrier(xbar); }
    }
}

extern "C" void kernel_launch(void* const* d_in, const int* in_sizes, int n_in, void* d_out, int out_size, void* d_ws, size_t ws_size, hipStream_t stream) {
    static int grid = 0;
    if (grid == 0) {
        if (n_in != 19 || out_size != MTOK * DM || ws_size < WS_END) { fprintf(stderr, "kernel_launch: unexpected shapes (n_in %d out %d ws %zu)\n", n_in, out_size, ws_size); grid = -1; return; }
        int dev = 0, cus = 0, per_cu = 0;
        hipGetDevice(&dev); hipDeviceGetAttribute(&cus, hipDeviceAttributeMultiprocessorCount, dev);
        if (hipFuncSetAttribute((const void*)fwd_mega, hipFuncAttributeMaxDynamicSharedMemorySize, LDS_BYTES) != hipSuccess) { fprintf(stderr, "kernel_launch: hipFuncSetAttribute failed\n"); grid = -1; return; }
        hipOccupancyMaxActiveBlocksPerMultiprocessor(&per_cu, (const void*)fwd_mega, 512, LDS_BYTES);
        (void)hipGetLastError();
        if (cus != 256 || per_cu < 1) fprintf(stderr, "kernel_launch: note: cus %d per_cu %d (built for 256 x 1)\n", cus, per_cu);
        grid = 256;
    }
    if (grid < 0) return;
    Args a{};
    a.x = (const float*)d_in[0]; a.wg = (const float*)d_in[1]; a.wu = (const float*)d_in[2]; a.wd = (const float*)d_in[3]; a.lng = (const float*)d_in[4]; a.lnb = (const float*)d_in[5];
    a.ssm_win = (const float*)d_in[6]; a.ssm_cw = (const float*)d_in[7]; a.ssm_cb = (const float*)d_in[8]; a.ssm_dtb = (const float*)d_in[9]; a.ssm_alog = (const float*)d_in[10];
    a.ssm_d = (const float*)d_in[11]; a.ssm_nw = (const float*)d_in[12]; a.ssm_wout = (const float*)d_in[13]; a.fox_win = (const float*)d_in[14]; a.fox_bf = (const float*)d_in[15];
    a.fox_wout = (const float*)d_in[16]; a.moba_win = (const float*)d_in[17]; a.moba_wout = (const float*)d_in[18];
    a.out = (float*)d_out; a.ws = (unsigned char*)d_ws;
    if (hipMemsetAsync((char*)d_ws + WS_CTL, 0, CTL_BYTES, stream) != hipSuccess) { fprintf(stderr, "kernel_launch: memset failed\n"); return; }
#if MK_MULTI
    for (int ph = 0; ph < N_PHASES; ++ph) { a.ph_lo = ph; a.ph_hi = ph + 1; hipLaunchKernelGGL(fwd_mega, dim3(grid), dim3(512), LDS_BYTES, stream, a); }
#else
    a.ph_lo = 0; a.ph_hi = N_PHASES;
    void* args[] = {&a};
    hipError_t e = hipLaunchCooperativeKernel((const void*)fwd_mega, dim3(grid), dim3(512), args, LDS_BYTES, stream);
    if (e != hipSuccess) fprintf(stderr, "cooperative launch failed: %s\n", hipGetErrorString(e));
#endif
}
```

```cpp
#include <hip/hip_runtime.h>
#include <hip/hip_cooperative_groups.h>
#include <cstdio>
#include <cstdint>
namespace cg = cooperative_groups;
#ifndef MK_MULTI
#define MK_MULTI 0
#endif
namespace pg8 {
#define PG8_LAS __attribute__((address_space(3)))
typedef unsigned short bf16_t;
typedef short bf16x8 __attribute__((ext_vector_type(8)));
typedef float f32x4 __attribute__((ext_vector_type(4)));
typedef unsigned u32x4 __attribute__((ext_vector_type(4)));
constexpr int BM = 256, BK = 64, HALF = 128, HTB = HALF * BK * 2  , STAGE_BYTES = 8 * HTB, NXCD = 8, WGM = 8;

__host__ __device__ __forceinline__ int lds_byte(int r, int c) { const int st = (r >> 4) * 2 + (c >> 5), rr = r & 15, cc = c & 31, ob = rr * 64 + cc * 2; return st * 1024 + (ob ^ (((ob >> 9) & 1) << 5)); }
__host__ __device__ __forceinline__ void stage_rc(int b, int& R, int& C) { const int st = b / 1024, sb = b % 1024, swz = sb ^ (((sb >> 9) & 1) << 5); R = (st >> 1) * 16 + swz / 64; C = (st & 1) * 32 + (swz % 64) / 2; }
__host__ __device__ __forceinline__ int perm32(int rho) { const int n = rho >> 4, i = rho & 15; return 8 * (i >> 2) + 4 * n + (i & 3); }

struct Unit { int pm, pn; };
struct Gemm { const bf16_t* A; const bf16_t* Bt; int M, N, K; };

struct StaticOrder {
    int nM, nN, nwg, G, c;
    __host__ __device__ void init(int M, int N, int G_, int c_) { nM = M / BM; nN = N / BM; nwg = nM * nN; G = G_; c = c_; }
    __host__ __device__ bool next(int i, Unit& u) const {
        const long L = (long)i * G + c; if (L >= nwg) return false;
        int wgid = (int)L; { const int q = nwg / NXCD, r = nwg % NXCD, xcd = wgid % NXCD, off = wgid / NXCD; wgid = (xcd < r ? xcd * (q + 1) : r * (q + 1) + (xcd - r) * q) + off; }
        const int nig = WGM * nN, gid = wgid / nig, fm = gid * WGM, gsz = (nM - fm) < WGM ? (nM - fm) : WGM;
        u.pm = fm + ((wgid % nig) % gsz); u.pn = (wgid % nig) / gsz; return true;
    }
    __device__ __forceinline__ void a_ready(const Unit&) const {}
    __device__ __forceinline__ void done(const Unit&) const {}
};
template <class Epi, class Sched, bool ALIGN_EPI = false, bool SP2 = false>
__device__ __forceinline__ void gemm_phase(PG8_LAS unsigned char* lds, const Gemm g, const Sched& S, const Epi& E) {
    const int tid = threadIdx.x, wid = __builtin_amdgcn_readfirstlane(tid >> 6), lane = tid & 63, wr = wid >> 2, wc = wid & 3, fr = lane & 15, fq = lane >> 4;
    const int K = g.K, nt = K / BK;
    unsigned voffA[2], voffB[2];
#pragma unroll
    for (int i = 0; i < 2; ++i) { int R, C; stage_rc(tid * 16 + i * 8192, R, C); const int Rb = Epi::PERM ? ((R & ~31) + perm32(R & 31)) : R;
        voffA[i] = (unsigned)(R * K + C) * 2u; voffB[i] = (unsigned)(Rb * K + C) * 2u; }
    const size_t kstep = (size_t)(BK * 2);
    const size_t hstep = (size_t)HALF * K * 2;
    const size_t tstep = 2 * hstep;
    const unsigned ldsw = (unsigned)wid * 1024u;
    const int aoff = lds_byte(wr * 64 + fr, fq * 8), boff = lds_byte(wc * 32 + fr, fq * 8);
#define PG8_SA(b, h) (((b) * 2 + (h)) * HTB)
#define PG8_SB(b, h) ((4 + (b) * 2 + (h)) * HTB)
#define PG8_STAGE(bufoff, gbase, voff) do { _Pragma("unroll") for (int _i = 0; _i < 2; ++_i) \
        __builtin_amdgcn_global_load_lds((const unsigned*)((const char*)(gbase) + (voff)[_i]), (PG8_LAS unsigned*)(lds + (bufoff) + ldsw + _i * 8192), 16, 0, 0); } while (0)
#define PG8_LDA(dst, b, h) do { _Pragma("unroll") for (int m = 0; m < 4; ++m) _Pragma("unroll") for (int k = 0; k < 2; ++k) dst[m][k] = *(const PG8_LAS bf16x8*)(lds + PG8_SA(b, h) + aoff + m * 2048 + k * 1024); } while (0)
#define PG8_LDB(dst, b, h) do { _Pragma("unroll") for (int n = 0; n < 2; ++n) _Pragma("unroll") for (int k = 0; k < 2; ++k) dst[n][k] = *(const PG8_LAS bf16x8*)(lds + PG8_SB(b, h) + boff + n * 2048 + k * 1024); } while (0)
#define PG8_MMA(ai, bj, At, Bt) do { __builtin_amdgcn_s_setprio(1); _Pragma("unroll") for (int m = 0; m < 4; ++m) _Pragma("unroll") for (int n = 0; n < 2; ++n) _Pragma("unroll") for (int k = 0; k < 2; ++k) \
        acc[ai][bj][m][n] = __builtin_amdgcn_mfma_f32_16x16x32_bf16(Bt[n][k], At[m][k], acc[ai][bj][m][n], 0, 0, 0); __builtin_amdgcn_s_setprio(0); } while (0)
#define PG8_WAIT_V(n) asm volatile("s_waitcnt vmcnt(" #n ")" ::: "memory")
#define PG8_WAIT_L(n) asm volatile("s_waitcnt lgkmcnt(" #n ")" ::: "memory")
#define PG8_BAR __builtin_amdgcn_s_barrier()
#define PG8_SCHED __builtin_amdgcn_sched_barrier(0)
    Unit cur, nxt; int ui = 0;
    if (!S.next(0, cur)) return;
    f32x4 acc[2][2][4][2];
#pragma unroll
    for (int a = 0; a < 2; ++a)
#pragma unroll
        for (int b = 0; b < 2; ++b)
#pragma unroll
            for (int m = 0; m < 4; ++m)
#pragma unroll
                for (int n = 0; n < 2; ++n) acc[a][b][m][n] = (f32x4){0.f, 0.f, 0.f, 0.f};
    bf16x8 At[4][2], B0[2][2], B1[2][2];
    const char* cA = (const char*)g.A + (size_t)cur.pm * tstep; const char* cB = (const char*)g.Bt + (size_t)cur.pn * tstep;
    S.a_ready(cur);
    if constexpr (SP2) {
        PG8_STAGE(PG8_SB(0, 0), cB, voffB); PG8_STAGE(PG8_SB(0, 1), cB + hstep, voffB); PG8_STAGE(PG8_SA(0, 0), cA, voffA); PG8_STAGE(PG8_SA(0, 1), cA + hstep, voffA);
        if (wr == 1) PG8_BAR;
        PG8_WAIT_V(2); PG8_BAR;
        PG8_STAGE(PG8_SB(1, 0), cB + kstep, voffB); PG8_STAGE(PG8_SA(1, 0), cA + kstep, voffA); PG8_STAGE(PG8_SB(1, 1), cB + hstep + kstep, voffB);
        PG8_WAIT_V(6); PG8_BAR;
    } else {
        PG8_STAGE(PG8_SB(0, 0), cB, voffB); PG8_STAGE(PG8_SA(0, 0), cA, voffA); PG8_STAGE(PG8_SB(0, 1), cB + hstep, voffB); PG8_STAGE(PG8_SA(0, 1), cA + hstep, voffA);
        if (wr == 1) PG8_BAR;
        PG8_WAIT_V(4); PG8_BAR;
        PG8_STAGE(PG8_SB(1, 0), cB + kstep, voffB); PG8_STAGE(PG8_SA(1, 0), cA + kstep, voffA); PG8_STAGE(PG8_SB(1, 1), cB + hstep + kstep, voffB);
        PG8_WAIT_V(6); PG8_BAR;
    }
    for (;;) {
        const bool has_next = S.next(ui + 1, nxt);
        const char* nA = has_next ? (const char*)g.A + (size_t)nxt.pm * tstep : cA; const char* nB = has_next ? (const char*)g.Bt + (size_t)nxt.pn * tstep : cB;
        for (int t = 0; t < nt; t += 2) {
            const bool last = (t == nt - 2);
            const char* a1 = cA + (size_t)(t + 1) * kstep;
            const char* a2 = last ? nA : cA + (size_t)(t + 2) * kstep; const char* b2 = last ? nB : cB + (size_t)(t + 2) * kstep;
            const char* a3 = a2 + kstep; const char* b3 = b2 + kstep;
            if (last && has_next) S.a_ready(nxt);
            if constexpr (SP2) {
            PG8_LDB(B0, 0, 0); PG8_LDB(B1, 0, 1); PG8_SCHED; PG8_LDA(At, 0, 0); PG8_STAGE(PG8_SA(1, 1), a1 + hstep, voffA);
            PG8_WAIT_V(8); PG8_WAIT_L(0); PG8_BAR; PG8_MMA(0, 0, At, B0); PG8_MMA(0, 1, At, B1); PG8_BAR; PG8_SCHED;
            PG8_LDA(At, 0, 1); PG8_STAGE(PG8_SB(0, 0), b2, voffB); PG8_STAGE(PG8_SB(0, 1), b2 + hstep, voffB); PG8_STAGE(PG8_SA(0, 0), a2, voffA);
            PG8_WAIT_V(8); PG8_WAIT_L(0); PG8_BAR; PG8_MMA(1, 0, At, B0); PG8_MMA(1, 1, At, B1); PG8_BAR; PG8_SCHED;
            PG8_LDB(B0, 1, 0); PG8_LDB(B1, 1, 1); PG8_SCHED; PG8_LDA(At, 1, 0); PG8_STAGE(PG8_SA(0, 1), a2 + hstep, voffA);
            PG8_WAIT_V(8); PG8_WAIT_L(0); PG8_BAR; PG8_MMA(0, 0, At, B0); PG8_MMA(0, 1, At, B1); PG8_BAR; PG8_SCHED;
            PG8_LDA(At, 1, 1); PG8_STAGE(PG8_SB(1, 0), b3, voffB); PG8_STAGE(PG8_SB(1, 1), b3 + hstep, voffB); PG8_STAGE(PG8_SA(1, 0), a3, voffA);
            PG8_WAIT_V(8); PG8_WAIT_L(0); PG8_BAR; PG8_MMA(1, 0, At, B0); PG8_MMA(1, 1, At, B1); PG8_BAR; PG8_SCHED;
            } else {
            PG8_LDB(B0, 0, 0); PG8_SCHED; PG8_LDA(At, 0, 0); PG8_STAGE(PG8_SA(1, 1), a1 + hstep, voffA);
            PG8_WAIT_L(8); PG8_BAR; PG8_WAIT_L(0); PG8_MMA(0, 0, At, B0); PG8_BAR; PG8_SCHED;
            PG8_LDB(B1, 0, 1); PG8_STAGE(PG8_SB(0, 0), b2, voffB);
            PG8_BAR; PG8_WAIT_L(0); PG8_MMA(0, 1, At, B1); PG8_BAR;
            PG8_LDA(At, 0, 1); PG8_STAGE(PG8_SA(0, 0), a2, voffA);
            PG8_BAR; PG8_WAIT_L(0); PG8_MMA(1, 0, At, B0); PG8_BAR; PG8_SCHED;
            PG8_STAGE(PG8_SB(0, 1), b2 + hstep, voffB);
            PG8_WAIT_V(6); PG8_BAR; PG8_MMA(1, 1, At, B1); PG8_BAR;
            PG8_LDB(B0, 1, 0); PG8_SCHED; PG8_LDA(At, 1, 0); PG8_STAGE(PG8_SA(0, 1), a2 + hstep, voffA);
            PG8_WAIT_L(8); PG8_BAR; PG8_WAIT_L(0); PG8_MMA(0, 0, At, B0); PG8_BAR; PG8_SCHED;
            PG8_LDB(B1, 1, 1); PG8_STAGE(PG8_SB(1, 0), b3, voffB);
            PG8_BAR; PG8_WAIT_L(0); PG8_MMA(0, 1, At, B1); PG8_BAR;
            PG8_LDA(At, 1, 1); PG8_STAGE(PG8_SA(1, 0), a3, voffA);
            PG8_BAR; PG8_WAIT_L(0); PG8_MMA(1, 0, At, B0); PG8_BAR; PG8_SCHED;
            PG8_STAGE(PG8_SB(1, 1), b3 + hstep, voffB);
            PG8_WAIT_V(6); PG8_BAR; PG8_MMA(1, 1, At, B1); PG8_BAR;
            }
        }
        if constexpr (ALIGN_EPI) { if (wr == 0) PG8_BAR; }
        if constexpr (!Epi::AFTER_DRAIN) { E(acc, cur, wr, wc, fr, fq); S.done(cur); }
        if (!has_next) break;
#pragma unroll
        for (int a = 0; a < 2; ++a)
#pragma unroll
            for (int b = 0; b < 2; ++b)
#pragma unroll
                for (int m = 0; m < 4; ++m)
#pragma unroll
                    for (int n = 0; n < 2; ++n) acc[a][b][m][n] = (f32x4){0.f, 0.f, 0.f, 0.f};
        cur = nxt; cA = nA; cB = nB; ++ui;
        if constexpr (ALIGN_EPI) { if (wr == 1) PG8_BAR; }
    }
    PG8_WAIT_V(0);
    if constexpr (!ALIGN_EPI) { if (wr == 0) PG8_BAR; }
    PG8_BAR;
    if constexpr (Epi::AFTER_DRAIN) { E.fused(acc, cur, wr, wc, fr, fq, lds, wid, lane); S.done(cur); }
#undef PG8_SA
#undef PG8_SB
#undef PG8_STAGE
#undef PG8_LDA
#undef PG8_LDB
#undef PG8_MMA
#undef PG8_WAIT_V
#undef PG8_WAIT_L
#undef PG8_BAR
#undef PG8_SCHED
}
}

#define LAS __attribute__((address_space(3)))
typedef unsigned short bf16;
typedef float f32x4 __attribute__((ext_vector_type(4)));
typedef float f32x16 __attribute__((ext_vector_type(16)));
typedef short bf16x8 __attribute__((ext_vector_type(8)));
typedef unsigned u32x4 __attribute__((ext_vector_type(4)));
typedef unsigned u32x2 __attribute__((ext_vector_type(2)));
typedef float f32x2_t __attribute__((ext_vector_type(2)));
typedef __bf16 bf16x2_t __attribute__((ext_vector_type(2)));

constexpr int SEQ = 8192, MTOK = 16384, DM = 1024, DFF = 2816;
constexpr float ALPHA = 1.6817928305074290f;
constexpr float LOG2E = 1.4426950408889634f;
constexpr float QSCALE = 0.125f * LOG2E;
constexpr float LN_EPS = 1e-5f;
constexpr size_t MiB = 1u << 20;
constexpr size_t WS_WGU0 = 0, WS_WD0 = 11 * MiB, WS_WGU1 = 33 * MiB / 2, WS_WD1 = 55 * MiB / 2, WS_WIN = 33 * MiB, WS_WOUT = 87 * MiB / 2;
constexpr size_t WS_H16 = 48 * MiB, WS_BM = 48 * MiB, WS_CM = 64 * MiB;
constexpr size_t WS_Z = 80 * MiB, WS_Q = 80 * MiB, WS_K = 112 * MiB, WS_ACT = 80 * MiB;
constexpr size_t WS_XBC = 144 * MiB, WS_ST = 144 * MiB, WS_SIN = 208 * MiB, WS_VT = 144 * MiB, WS_O = 176 * MiB;
constexpr size_t WS_XT = 240 * MiB, WS_Y = 240 * MiB, WS_BT = 304 * MiB, WS_YD = 320 * MiB;
constexpr size_t WS_CTL = 391 * MiB, CTL_BYTES = 65536;
constexpr int L_XBST = 147392;
constexpr size_t WS_DT = 384 * MiB, WS_ACS = 386 * MiB, WS_LF = 388 * MiB, WS_CUM = 389 * MiB, WS_KM = 390 * MiB, WS_END = 392 * MiB;
constexpr int LDS_BYTES = 147456;

__device__ __forceinline__ unsigned pk2(float lo, float hi) { f32x2_t v = {lo, hi}; bf16x2_t b = __builtin_convertvector(v, bf16x2_t); return __builtin_bit_cast(unsigned, b); }
__device__ __forceinline__ float bflo(unsigned x) { return __uint_as_float(x << 16); }
__device__ __forceinline__ float bfhi(unsigned x) { return __uint_as_float(x & 0xffff0000u); }
__device__ __forceinline__ float siluf(float v) { return v / (1.f + __expf(-v)); }
__device__ __forceinline__ int crow(int r, int hi) { return (r & 3) + 8 * (r >> 2) + 4 * hi; }
__device__ __forceinline__ float wave_sum(float v) {
#pragma unroll
    for (int o = 1; o < 64; o <<= 1) v += __shfl_xor(v, o);
    return v;
}

struct Args {
    const float *x, *wg, *wu, *wd, *lng, *lnb, *ssm_win, *ssm_cw, *ssm_cb, *ssm_dtb, *ssm_alog, *ssm_d, *ssm_nw, *ssm_wout,
        *fox_win, *fox_bf, *fox_wout, *moba_win, *moba_wout;
    float* out; unsigned char* ws; int ph_lo, ph_hi;
};

struct Epi {
    static constexpr bool PERM = false, AFTER_DRAIN = false;
    int mode; float w;
    float* out; unsigned char* ws; const float* bias;
    __device__ __forceinline__ void operator()(const pg8::f32x4 (&acc)[2][2][4][2], const pg8::Unit& u, int wr, int wc, int fr, int fq) const {
        const int row0 = u.pm * 256 + wr * 64 + fr;
        const int bb = u.pm >> 5;
        if (mode == 0) {
            const int colh = u.pn * 128 + wc * 32 + 4 * fq;
#pragma unroll
            for (int ai = 0; ai < 2; ++ai)
#pragma unroll
                for (int m = 0; m < 4; ++m) {
                    bf16* rp = (bf16*)(ws + WS_ACT) + (size_t)(row0 + ai * 128 + m * 16) * DFF + colh;
#pragma unroll
                    for (int n = 0; n < 2; ++n) {
                        const f32x4 g = acc[ai][0][m][n], uu = acc[ai][1][m][n];
                        u32x2 v; v.x = pk2(siluf(g[0]) * uu[0], siluf(g[1]) * uu[1]); v.y = pk2(siluf(g[2]) * uu[2], siluf(g[3]) * uu[3]);
                        *(u32x2*)(rp + 16 * n) = v;
                    }
                    asm volatile("" ::: "memory");
                }
        } else if (mode == 1) {
            const int col0 = u.pn * 256 + wc * 32 + 4 * fq;
#pragma unroll
            for (int ai = 0; ai < 2; ++ai)
#pragma unroll
                for (int m = 0; m < 4; ++m) {
                    float* rp = out + (size_t)(row0 + ai * 128 + m * 16) * DM + col0;
#pragma unroll
                    for (int bj = 0; bj < 2; ++bj)
#pragma unroll
                        for (int n = 0; n < 2; ++n) {
                            f32x4* p = (f32x4*)(rp + bj * 128 + 16 * n);
                            const f32x4 v = *p; *p = v * ALPHA + acc[ai][bj][m][n] * w;
                        }
                    asm volatile("" ::: "memory");
                }
        } else if (mode == 2) {
            if (u.pn < 20) {
                bf16* base; int ld, colt;
                if (u.pn < 8) { base = (bf16*)(ws + WS_Z); ld = 2048; colt = u.pn * 256; } else { base = (bf16*)(ws + WS_XBC); ld = 3072; colt = (u.pn - 8) * 256; }
                const int col0 = colt + wc * 32 + 4 * fq;
#pragma unroll
                for (int ai = 0; ai < 2; ++ai)
#pragma unroll
                    for (int m = 0; m < 4; ++m) {
                        bf16* rp = base + (size_t)(row0 + ai * 128 + m * 16) * ld + col0;
#pragma unroll
                        for (int bj = 0; bj < 2; ++bj)
#pragma unroll
                            for (int n = 0; n < 2; ++n) {
                                const f32x4 a = acc[ai][bj][m][n]; u32x2 v; v.x = pk2(a[0], a[1]); v.y = pk2(a[2], a[3]);
                                *(u32x2*)(rp + bj * 128 + 16 * n) = v;
                            }
                        asm volatile("" ::: "memory");
                    }
            } else if (wc == 0) {
#pragma unroll
                for (int n = 0; n < 2; ++n) {
                    const int hd = 16 * n + 4 * fq;
#pragma unroll
                    for (int j = 0; j < 4; ++j) {
                        const float bsv = bias[hd + j];
                        float* dp = (float*)(ws + WS_DT) + (size_t)(bb * 32 + hd + j) * SEQ;
#pragma unroll
                        for (int ai = 0; ai < 2; ++ai)
#pragma unroll
                            for (int m = 0; m < 4; ++m) {
                                const int s = (row0 + ai * 128 + m * 16) & (SEQ - 1);
                                const float xv = acc[ai][0][m][n][j] + bsv;
                                dp[s] = xv > 20.f ? xv : log1pf(__expf(xv));
                            }
                    }
                }
            }
        } else {
            if (u.pn < 8) {
                bf16* base = (bf16*)(ws + (u.pn < 4 ? WS_Q : WS_K)); const float sc = u.pn < 4 ? QSCALE : 1.f;
                const int col0 = (u.pn & 3) * 256 + wc * 32 + 4 * fq;
#pragma unroll
                for (int ai = 0; ai < 2; ++ai)
#pragma unroll
                    for (int m = 0; m < 4; ++m) {
                        bf16* rp = base + (size_t)(row0 + ai * 128 + m * 16) * DM + col0;
#pragma unroll
                        for (int bj = 0; bj < 2; ++bj)
#pragma unroll
                            for (int n = 0; n < 2; ++n) {
                                const f32x4 a = acc[ai][bj][m][n] * sc; u32x2 v; v.x = pk2(a[0], a[1]); v.y = pk2(a[2], a[3]);
                                *(u32x2*)(rp + bj * 128 + 16 * n) = v;
                            }
                        asm volatile("" ::: "memory");
                    }
            } else if (u.pn < 12) {
#pragma unroll
                for (int bj = 0; bj < 2; ++bj)
#pragma unroll
                    for (int n = 0; n < 2; ++n) {
                        const int c = (u.pn - 8) * 256 + bj * 128 + wc * 32 + 16 * n + 4 * fq;
#pragma unroll
                        for (int j = 0; j < 4; ++j) {
                            bf16* vp = (bf16*)(ws + WS_VT) + (size_t)((bb * 16 + ((c + j) >> 6)) * 64 + ((c + j) & 63)) * SEQ;
#pragma unroll
                            for (int ai = 0; ai < 2; ++ai)
#pragma unroll
                                for (int m = 0; m < 4; ++m) {
                                    const int s = (row0 + ai * 128 + m * 16) & (SEQ - 1);
                                    vp[s] = (bf16)(pk2(acc[ai][bj][m][n][j], 0.f) & 0xffffu);
                                }
                        }
                    }
            } else if (wc == 0 && fq < 4) {
#pragma unroll
                for (int j = 0; j < 4; ++j) {
                    const int hd = 4 * fq + j; const float bsv = bias[hd];
                    float* dp = (float*)(ws + WS_LF) + (size_t)(bb * 16 + hd) * SEQ;
#pragma unroll
                    for (int ai = 0; ai < 2; ++ai)
#pragma unroll
                        for (int m = 0; m < 4; ++m) {
                            const int s = (row0 + ai * 128 + m * 16) & (SEQ - 1);
                            const float xv = acc[ai][0][m][0][j] + bsv;
                            dp[s] = xv >= 0.f ? -log1pf(__expf(-xv)) : xv - log1pf(__expf(xv));
                        }
                }
            }
        }
    }
};

struct EpiRes {
    static constexpr bool PERM = false, AFTER_DRAIN = false;
    float w; float* out;
    __device__ __forceinline__ void operator()(const pg8::f32x4 (&acc)[2][2][4][2], const pg8::Unit& u, int wr, int wc, int fr, int fq) const {
        const int row0 = u.pm * 256 + wr * 64 + fr, col0 = u.pn * 256 + wc * 32 + 4 * fq;
#pragma unroll
        for (int ai = 0; ai < 2; ++ai)
#pragma unroll
            for (int m = 0; m < 4; ++m) {
                float* rp = out + (size_t)(row0 + ai * 128 + m * 16) * DM + col0;
#pragma unroll
                for (int bj = 0; bj < 2; ++bj)
#pragma unroll
                    for (int n = 0; n < 2; ++n) { f32x4* p = (f32x4*)(rp + bj * 128 + 16 * n); const f32x4 v = *p; *p = v * ALPHA + acc[ai][bj][m][n] * w; }
                asm volatile("" ::: "memory");
            }
    }
};
__device__ __forceinline__ void tr_item(const float* W, int K, int N, bf16* WT, int dst_row0, const float* kscale, LAS float* scr, int k0, int n0, int lane) {
    const int nn = n0 + (lane & 31);
#pragma unroll 8
    for (int i = 0; i < 32; ++i) {
        const int kk = 2 * i + (lane >> 5);
        float v = nn < N ? W[(size_t)(k0 + kk) * N + nn] : 0.f;
        if (kscale) v *= kscale[k0 + kk];
        scr[kk * 33 + (lane & 31)] = v;
    }
    asm volatile("s_waitcnt lgkmcnt(0)" ::: "memory");
    const int c = lane & 7;
#pragma unroll
    for (int j = 0; j < 4; ++j) {
        const int n = (lane >> 3) + 8 * j; const LAS float* s = scr + (8 * c) * 33 + n;
        u32x4 o; o.x = pk2(s[0 * 33], s[1 * 33]); o.y = pk2(s[2 * 33], s[3 * 33]); o.z = pk2(s[4 * 33], s[5 * 33]); o.w = pk2(s[6 * 33], s[7 * 33]);
        *(u32x4*)(WT + (size_t)(dst_row0 + n) * K + k0 + 8 * c) = o;
    }
    asm volatile("s_waitcnt lgkmcnt(0)" ::: "memory");
}
struct MatD { const float* W; int K, N; bf16* WT; int kind; const float* ks; };
__device__ __forceinline__ MatD get_mat(const Args& a, int L, int mi) {
    MatD d; d.ks = nullptr; d.kind = 0;
    const int kind = L % 3, j = L / 3;
    unsigned char* ws = a.ws; asm volatile("" : "+s"(ws));
    if (mi < 6) {
        const int h = mi / 3, t = mi % 3; const size_t lo = (size_t)(L * 2 + h) * DM * DFF;
        if (t == 0) { d.W = a.wg + lo; d.K = DM; d.N = DFF; d.WT = (bf16*)(ws + (h ? WS_WGU1 : WS_WGU0)); d.kind = 1; }
        else if (t == 1) { d.W = a.wu + lo; d.K = DM; d.N = DFF; d.WT = (bf16*)(ws + (h ? WS_WGU1 : WS_WGU0)); d.kind = 2; }
        else { d.W = a.wd + lo; d.K = DFF; d.N = DM; d.WT = (bf16*)(ws + (h ? WS_WD1 : WS_WD0)); }
    } else if (mi == 6) {
        d.K = DM; d.WT = (bf16*)(ws + WS_WIN);
        if (kind == 0) { d.W = a.ssm_win + (size_t)j * DM * 5152; d.N = 5152; }
        else if (kind == 1) { d.W = a.fox_win + (size_t)j * DM * 3088; d.N = 3088; }
        else { d.W = a.moba_win + (size_t)j * DM * 3072; d.N = 3072; }
    } else {
        d.N = DM; d.WT = (bf16*)(ws + WS_WOUT);
        if (kind == 0) { d.W = a.ssm_wout + (size_t)j * 2048 * DM; d.K = 2048; d.ks = a.ssm_nw + j * 2048; }
        else if (kind == 1) { d.W = a.fox_wout + (size_t)j * DM * DM; d.K = DM; }
        else { d.W = a.moba_wout + (size_t)j * DM * DM; d.K = DM; }
    }
    return d;
}
__device__ __forceinline__ void convert_layer(const Args& a, int L, LAS unsigned char* lds, int gw, int NGW, int wid, int lane) {
    LAS float* scr = (LAS float*)(lds + wid * 8448);
    for (int mi = 0; mi < 8; ++mi) {
        const MatD d = get_mat(a, L, mi);
        const int nnb = (d.N + 31) / 32, cnt = (d.K / 64) * nnb;
        for (int it = gw; it < cnt; it += NGW) {
            const int kb = it / nnb, nb = it % nnb, n0 = nb * 32;
            const int dr = d.kind == 0 ? n0 : ((n0 >> 7) * 256 + (n0 & 127) + (d.kind == 2 ? 128 : 0));
            tr_item(d.W, d.K, d.N, d.WT, dr, d.ks, scr, kb * 64, n0, lane);
        }
    }
}

__device__ __forceinline__ void ln_pass(float* out, bf16* h16, const float* g, const float* bta, int gw, int NGW, int lane) {
    f32x4 gg[4], bb[4];
#pragma unroll
    for (int j = 0; j < 4; ++j) { gg[j] = *((const f32x4*)g + lane + 64 * j); bb[j] = *((const f32x4*)bta + lane + 64 * j); }
    f32x4 nx[4];
    if (gw < MTOK) {
        const f32x4* xr0 = (const f32x4*)(out + (size_t)gw * DM) + lane;
#pragma unroll
        for (int j = 0; j < 4; ++j) nx[j] = xr0[64 * j];
    }
    for (int row = gw; row < MTOK; row += NGW) {
        f32x4* xr = (f32x4*)(out + (size_t)row * DM) + lane;
        f32x4 v[4]; float s = 0.f;
#pragma unroll
        for (int j = 0; j < 4; ++j) { v[j] = nx[j]; s += (v[j][0] + v[j][1]) + (v[j][2] + v[j][3]); }
        if (row + NGW < MTOK) {
            const f32x4* xn = (const f32x4*)(out + (size_t)(row + NGW) * DM) + lane;
#pragma unroll
            for (int j = 0; j < 4; ++j) nx[j] = xn[64 * j];
        }
        const float mean = wave_sum(s) * (1.f / DM); float s2 = 0.f;
#pragma unroll
        for (int j = 0; j < 4; ++j) { v[j] = v[j] - mean; s2 += (v[j][0] * v[j][0] + v[j][1] * v[j][1]) + (v[j][2] * v[j][2] + v[j][3] * v[j][3]); }
        const float rstd = 1.f / sqrtf(wave_sum(s2) * (1.f / DM) + LN_EPS);
        u32x2* o8 = (u32x2*)(h16 + (size_t)row * DM) + lane;
#pragma unroll
        for (int j = 0; j < 4; ++j) {
            const f32x4 y = v[j] * rstd * gg[j] + bb[j];
            xr[64 * j] = y;
            u32x2 p; p.x = pk2(y[0], y[1]); p.y = pk2(y[2], y[3]); o8[64 * j] = p;
        }
    }
}

__device__ __forceinline__ void conv_phase(const Args& a, int jj, LAS unsigned char* lds, int bid, int G, int tid, int wid, int lane) {
    unsigned char* ws = a.ws; asm volatile("" : "+s"(ws));
    const bf16* XBC = (const bf16*)(ws + WS_XBC);
    bf16* XT = (bf16*)(ws + WS_XT); bf16* BM = (bf16*)(ws + WS_BM); bf16* CMm = (bf16*)(ws + WS_CM); bf16* BT = (bf16*)(ws + WS_BT);
    const float* cw = a.ssm_cw + (size_t)jj * 4 * 3072; const float* cb = a.ssm_cb + (size_t)jj * 3072;
    for (int u = bid; u < 1536; u += G) {
        const int slab = u % 6, tt = (u / 6) % 128, b = u / 768;
        const int cp = tid & 255, tg = tid >> 8, ch = slab * 512 + 2 * cp, t0 = tt * 64 + tg * 32;
        float w0[4], w1[4];
#pragma unroll
        for (int k = 0; k < 4; ++k) { w0[k] = cw[k * 3072 + ch]; w1[k] = cw[k * 3072 + ch + 1]; }
        const float b0 = cb[ch], b1 = cb[ch + 1];
        const unsigned* src = (const unsigned*)(XBC + (size_t)(b * SEQ) * 3072 + ch);
        unsigned rv[35];
#pragma unroll
        for (int k = 0; k < 35; ++k) { const int t = t0 - 3 + k; unsigned v = 0u; if (t >= 0) v = src[(size_t)t * 1536]; rv[k] = v; }
        float xa[3], xb[3];
#pragma unroll
        for (int k = 0; k < 3; ++k) { xa[k] = bflo(rv[k]); xb[k] = bfhi(rv[k]); }
        __syncthreads();
#pragma unroll
        for (int i8 = 0; i8 < 4; ++i8) {
            unsigned oa[4], ob[4];
#pragma unroll
            for (int i = 0; i < 8; ++i) {
                const int t = t0 + i8 * 8 + i;
                const unsigned v = rv[3 + i8 * 8 + i];
                const float ca = bflo(v), cbv = bfhi(v);
                float ya = b0 + w0[0] * xa[0] + w0[1] * xa[1] + w0[2] * xa[2] + w0[3] * ca;
                float yb = b1 + w1[0] * xb[0] + w1[1] * xb[1] + w1[2] * xb[2] + w1[3] * cbv;
                xa[0] = xa[1]; xa[1] = xa[2]; xa[2] = ca; xb[0] = xb[1]; xb[1] = xb[2]; xb[2] = cbv;
                ya = siluf(ya); yb = siluf(yb);
                const unsigned pr = pk2(ya, yb);
                if (slab == 4) *(unsigned*)(BM + (size_t)(b * SEQ + t) * 512 + (ch - 2048)) = pr;
                if (slab == 5) *(unsigned*)(CMm + (size_t)(b * SEQ + t) * 512 + (ch - 2560)) = pr;
                if (i & 1) { oa[i >> 1] = (oa[i >> 1] & 0xffffu) | (pr << 16); ob[i >> 1] = (ob[i >> 1] & 0xffffu) | (pr & 0xffff0000u); }
                else { oa[i >> 1] = pr & 0xffffu; ob[i >> 1] = pr >> 16; }
            }
            if (slab < 5) {
                LAS unsigned char* tp = lds + (2 * cp) * 144 + (tg * 32 + i8 * 8) * 2;
                *(LAS u32x4*)tp = (u32x4){oa[0], oa[1], oa[2], oa[3]};
                *(LAS u32x4*)(tp + 144) = (u32x4){ob[0], ob[1], ob[2], ob[3]};
            }
        }
        __syncthreads();
        if (slab < 5) {
            bf16* dstb = (slab < 4) ? (XT + ((size_t)b * 2048 + slab * 512) * SEQ) : (BT + ((size_t)b * 512) * SEQ);
#pragma unroll
            for (int k = 0; k < 8; ++k) {
                const int idx = lane + 64 * k, chl = 64 * wid + (idx >> 3), pc = idx & 7;
                const u32x4 v = *(LAS u32x4*)(lds + chl * 144 + pc * 16);
                *(u32x4*)(dstb + (size_t)chl * SEQ + tt * 64 + pc * 8) = v;
            }
        }
    }
    const float* DT = (const float*)(ws + WS_DT); float* ACS = (float*)(ws + WS_ACS);
    for (int seg = bid * 8 + wid; seg < 2048; seg += G * 8) {
        const int b = seg >> 10, h = (seg >> 5) & 31, c = seg & 31;
        const float A = -__expf(a.ssm_alog[jj * 32 + h]);
        const size_t off = (size_t)(b * 32 + h) * SEQ + c * 256 + 4 * lane;
        f32x4 d = *(const f32x4*)(DT + off);
        f32x4 p; p[0] = d[0] * A; p[1] = p[0] + d[1] * A; p[2] = p[1] + d[2] * A; p[3] = p[2] + d[3] * A;
        float tot = p[3];
#pragma unroll
        for (int o = 1; o < 64; o <<= 1) { const float t = __shfl_up(tot, o); if (lane >= o) tot += t; }
        const float ex = tot - p[3];
        *(f32x4*)(ACS + off) = p + ex;
    }
}

__device__ __forceinline__ void ssd_diag_phase(const Args& a, int jj, LAS unsigned char* lds, int bid, int G, int tid, int wid, int lane) {
    unsigned char* ws = a.ws; asm volatile("" : "+s"(ws));
    const bf16* BM = (const bf16*)(ws + WS_BM); const bf16* CMm = (const bf16*)(ws + WS_CM); const bf16* XT = (const bf16*)(ws + WS_XT); const bf16* BT = (const bf16*)(ws + WS_BT);
    const float* DT = (const float*)(ws + WS_DT); const float* ACS = (const float*)(ws + WS_ACS);
    float* ST = (float*)(ws + WS_ST); unsigned* YD = (unsigned*)(ws + WS_YD);
    constexpr int L_BM = 0, L_XT = 69632, L_ACS = 103424, L_DT = 104448, L_WG = 105472;
    const int r32 = lane & 31, hi = lane >> 5;
    for (int u = bid; u < 2048; u += G) {
        const int b = u >> 10, c = (u >> 5) & 31, h = u & 31, g = h >> 3;
        const int lt = wid < 4 ? wid : 11 - wid;
        const float Dh = a.ssm_d[jj * 32 + h];
        const int l = 32 * lt + r32;
        bf16x8 cf[8];
#pragma unroll
        for (int ks = 0; ks < 8; ++ks) cf[ks] = *(const bf16x8*)(CMm + (size_t)(b * SEQ + c * 256 + l) * 512 + g * 128 + 16 * ks + 8 * hi);
        const int pt = wid & 1, nt = wid >> 1;
        bf16x8 btf[16];
        {
            const bf16* bp = BT + (size_t)((b * 4 + g) * 128 + 32 * nt + r32) * SEQ + c * 256 + 8 * hi;
#pragma unroll
            for (int ks = 0; ks < 16; ++ks) btf[ks] = *(const bf16x8*)(bp + 16 * ks);
        }
        __syncthreads();
#pragma unroll
        for (int k = 0; k < 8; ++k) {
            const int idx = tid + 512 * k, row = idx >> 4, pc = idx & 15;
            const u32x4 v = *(const u32x4*)(BM + (size_t)(b * SEQ + c * 256 + row) * 512 + g * 128 + pc * 8);
            *(LAS u32x4*)(lds + L_BM + row * 272 + pc * 16) = v;
        }
#pragma unroll
        for (int k = 0; k < 4; ++k) {
            const int idx = tid + 512 * k, row = idx >> 5, pc = idx & 31;
            const u32x4 v = *(const u32x4*)(XT + (size_t)((b * 32 + h) * 64 + row) * SEQ + c * 256 + pc * 8);
            *(LAS u32x4*)(lds + L_XT + row * 528 + pc * 16) = v;
        }
        if (tid < 256) {
            const size_t o = (size_t)(b * 32 + h) * SEQ + c * 256;
            const float ac = ACS[o + tid], dtv = DT[o + tid], al = ACS[o + 255];
            *(LAS float*)(lds + L_ACS + tid * 4) = ac * LOG2E;
            *(LAS float*)(lds + L_DT + tid * 4) = dtv;
            *(LAS float*)(lds + L_WG + tid * 4) = dtv * __expf(al - ac);
        }
        __syncthreads();
        {
            f32x16 st = f32x16{};
#pragma unroll
            for (int ks = 0; ks < 16; ++ks) {
                const u32x4 xr = *(LAS u32x4*)(lds + L_XT + (32 * pt + r32) * 528 + (16 * ks + 8 * hi) * 2);
                const f32x4 wa = *(LAS f32x4*)(lds + L_WG + (16 * ks + 8 * hi) * 4), wb = *(LAS f32x4*)(lds + L_WG + (16 * ks + 8 * hi + 4) * 4);
                u32x4 xs;
                xs.x = pk2(bflo(xr.x) * wa[0], bfhi(xr.x) * wa[1]); xs.y = pk2(bflo(xr.y) * wa[2], bfhi(xr.y) * wa[3]);
                xs.z = pk2(bflo(xr.z) * wb[0], bfhi(xr.z) * wb[1]); xs.w = pk2(bflo(xr.w) * wb[2], bfhi(xr.w) * wb[3]);
                st = __builtin_amdgcn_mfma_f32_32x32x16_bf16(__builtin_bit_cast(bf16x8, xs), btf[ks], st, 0, 0, 0);
            }
            float* sp = ST + (size_t)u * 8192 + 32 * nt + r32;
#pragma unroll
            for (int r = 0; r < 16; ++r) sp[(32 * pt + crow(r, hi)) * 128] = st[r];
        }
        const float acl = *(LAS float*)(lds + L_ACS + l * 4);
        f32x16 o[2]; o[0] = f32x16{}; o[1] = f32x16{};
        for (int j = 0; j <= lt; ++j) {
            f32x16 gt = f32x16{};
#pragma unroll
            for (int ks = 0; ks < 8; ++ks) {
                const bf16x8 bfr = *(LAS bf16x8*)(lds + L_BM + (32 * j + r32) * 272 + (16 * ks + 8 * hi) * 2);
                gt = __builtin_amdgcn_mfma_f32_32x32x16_bf16(bfr, cf[ks], gt, 0, 0, 0);
            }
            unsigned pw[8];
#pragma unroll
            for (int i = 0; i < 4; ++i) {
                const int sb = 32 * j + 8 * i + 4 * hi;
                const f32x4 a4 = *(LAS f32x4*)(lds + L_ACS + sb * 4), d4 = *(LAS f32x4*)(lds + L_DT + sb * 4);
                float pv[4];
#pragma unroll
                for (int q = 0; q < 4; ++q) {
                    float val = gt[4 * i + q] * __builtin_amdgcn_exp2f(acl - a4[q]) * d4[q];
                    if (j == lt) { const int s = sb + q; val = (s <= l) ? val : 0.f; if (s == l) val += Dh; }
                    pv[q] = val;
                }
                pw[2 * i] = pk2(pv[0], pv[1]); pw[2 * i + 1] = pk2(pv[2], pv[3]);
            }
#pragma unroll
            for (int ks = 0; ks < 2; ++ks) {
                const bf16x8 pf = __builtin_bit_cast(bf16x8, (u32x4){pw[4 * ks], pw[4 * ks + 1], pw[4 * ks + 2], pw[4 * ks + 3]});
#pragma unroll
                for (int d0 = 0; d0 < 2; ++d0) {
                    const LAS unsigned char* xp = lds + L_XT + (32 * d0 + r32) * 528 + (32 * j + 16 * ks + 4 * hi) * 2;
                    const u32x2 xa = *(const LAS u32x2*)xp, xb = *(const LAS u32x2*)(xp + 16);
                    const bf16x8 xf = __builtin_bit_cast(bf16x8, (u32x4){xa.x, xa.y, xb.x, xb.y});
                    o[d0] = __builtin_amdgcn_mfma_f32_32x32x16_bf16(xf, pf, o[d0], 0, 0, 0);
                }
            }
        }
        {
            unsigned* yd = YD + ((size_t)u * 8 + lt) * 1024 + lane;
#pragma unroll
            for (int d0 = 0; d0 < 2; ++d0)
#pragma unroll
                for (int r = 0; r < 16; r += 2) yd[(d0 * 8 + (r >> 1)) * 64] = pk2(o[d0][r], o[d0][r + 1]);
        }
    }
}

__device__ __forceinline__ void ssd_scan_phase(const Args& a, int bid, int G, int tid) {
    unsigned char* ws = a.ws; asm volatile("" : "+s"(ws));
    const float* ST = (const float*)(ws + WS_ST); bf16* SIN = (bf16*)(ws + WS_SIN); const float* ACS = (const float*)(ws + WS_ACS);
    for (int gt = bid * 512 + tid; gt < 131072; gt += G * 512) {
        const int b = gt >> 16, h = (gt >> 11) & 31, q4 = gt & 2047;
        f32x4 v[32];
#pragma unroll
        for (int c = 0; c < 32; ++c) v[c] = *(const f32x4*)(ST + ((size_t)((b * 32 + c) * 32 + h)) * 8192 + q4 * 4);
        f32x4 run = (f32x4){0.f, 0.f, 0.f, 0.f};
#pragma unroll
        for (int c = 0; c < 32; ++c) {
            u32x2 p; p.x = pk2(run[0], run[1]); p.y = pk2(run[2], run[3]);
            *(u32x2*)(SIN + ((size_t)((b * 32 + c) * 32 + h)) * 8192 + q4 * 4) = p;
            const float dec = __expf(ACS[(size_t)(b * 32 + h) * SEQ + c * 256 + 255]);
            run = run * dec + v[c];
        }
    }
}

__device__ __forceinline__ void ssd_out_phase(const Args& a, LAS unsigned char* lds, int bid, int G, int tid, int wid, int lane) {
    unsigned char* ws = a.ws; asm volatile("" : "+s"(ws));
    const bf16* CMm = (const bf16*)(ws + WS_CM); const bf16* SIN = (const bf16*)(ws + WS_SIN); const bf16* Z = (const bf16*)(ws + WS_Z);
    const unsigned* YD = (const unsigned*)(ws + WS_YD); const float* ACS = (const float*)(ws + WS_ACS); bf16* Y = (bf16*)(ws + WS_Y);
    const int r32 = lane & 31, hi = lane >> 5;
    LAS unsigned char* tz = lds + wid * 8704; LAS unsigned char* ty = tz + 4352;
    for (int u = bid; u < 256; u += G) {
        const int b = u >> 7, c = (u >> 2) & 31, g = u & 3;
        const int l = 32 * wid + r32; const size_t rowb = (size_t)b * SEQ + c * 256 + 32 * wid; const size_t row = rowb + r32;
        bf16x8 cf[8];
#pragma unroll
        for (int ks = 0; ks < 8; ++ks) cf[ks] = *(const bf16x8*)(CMm + row * 512 + g * 128 + 16 * ks + 8 * hi);
        float ssq = 0.f;
        for (int rr = 0; rr < 8; ++rr) {
            const int h = 8 * g + rr; const int uu = (b * 32 + c) * 32 + h;
            u32x4 zr[4];
#pragma unroll
            for (int k = 0; k < 4; ++k) { const int idx = lane + 64 * k, rw = idx >> 3, pc = idx & 7;
                zr[k] = *(const u32x4*)(Z + (rowb + rw) * 2048 + 64 * h + pc * 8); }
            bf16x8 sa[16];
#pragma unroll
            for (int d0 = 0; d0 < 2; ++d0)
#pragma unroll
                for (int ks = 0; ks < 8; ++ks) sa[d0 * 8 + ks] = *(const bf16x8*)(SIN + (size_t)uu * 8192 + (32 * d0 + r32) * 128 + 16 * ks + 8 * hi);
            asm volatile("" ::: "memory");
            const unsigned* yd = YD + ((size_t)uu * 8 + wid) * 1024 + lane;
            unsigned ydv[16];
#pragma unroll
            for (int k = 0; k < 16; ++k) ydv[k] = yd[k * 64];
            const float dec = __expf(ACS[(size_t)(b * 32 + h) * SEQ + c * 256 + l]);
#pragma unroll
            for (int k = 0; k < 4; ++k) { const int idx = lane + 64 * k, rw = idx >> 3, pc = idx & 7; *(LAS u32x4*)(tz + rw * 136 + pc * 16) = zr[k]; }
            f32x16 o[2]; o[0] = f32x16{}; o[1] = f32x16{};
#pragma unroll
            for (int d0 = 0; d0 < 2; ++d0)
#pragma unroll
                for (int ks = 0; ks < 8; ++ks) o[d0] = __builtin_amdgcn_mfma_f32_32x32x16_bf16(sa[d0 * 8 + ks], cf[ks], o[d0], 0, 0, 0);
            asm volatile("s_waitcnt lgkmcnt(0)" ::: "memory");
#pragma unroll
            for (int d0 = 0; d0 < 2; ++d0)
#pragma unroll
                for (int i = 0; i < 4; ++i) {
                    const int cl = 32 * d0 + 8 * i + 4 * hi;
                    const u32x2 z2 = *(LAS u32x2*)(tz + r32 * 136 + cl * 2);
                    const unsigned y01 = ydv[d0 * 8 + 2 * i], y23 = ydv[d0 * 8 + 2 * i + 1];
                    const float y0 = (o[d0][4 * i] * dec + bflo(y01)) * siluf(bflo(z2.x));
                    const float y1 = (o[d0][4 * i + 1] * dec + bfhi(y01)) * siluf(bfhi(z2.x));
                    const float y2 = (o[d0][4 * i + 2] * dec + bflo(y23)) * siluf(bflo(z2.y));
                    const float y3 = (o[d0][4 * i + 3] * dec + bfhi(y23)) * siluf(bfhi(z2.y));
                    ssq += (y0 * y0 + y1 * y1) + (y2 * y2 + y3 * y3);
                    u32x2 p; p.x = pk2(y0, y1); p.y = pk2(y2, y3);
                    *(LAS u32x2*)(ty + r32 * 136 + cl * 2) = p;
                }
            asm volatile("s_waitcnt lgkmcnt(0)" ::: "memory");
#pragma unroll
            for (int k = 0; k < 4; ++k) { const int idx = lane + 64 * k, rw = idx >> 3, pc = idx & 7;
                *(u32x4*)(Y + (rowb + rw) * 2048 + 64 * h + pc * 8) = *(LAS u32x4*)(ty + rw * 136 + pc * 16); }
            asm volatile("s_waitcnt lgkmcnt(0)" ::: "memory");
        }
        ssq += __shfl_xor(ssq, 32);
        const float rstd = 1.f / sqrtf(ssq * (1.f / 512.f) + LN_EPS);
        asm volatile("s_waitcnt vmcnt(0)" ::: "memory");
#pragma unroll 8
        for (int rw = 0; rw < 32; ++rw) {
            const float rs = __shfl(rstd, rw);
            u32x4* yp = (u32x4*)(Y + (rowb + rw) * 2048 + 512 * g) + lane;
            const u32x4 v = *yp; u32x4 p;
            p.x = pk2(bflo(v.x) * rs, bfhi(v.x) * rs); p.y = pk2(bflo(v.y) * rs, bfhi(v.y) * rs);
            p.z = pk2(bflo(v.z) * rs, bfhi(v.z) * rs); p.w = pk2(bflo(v.w) * rs, bfhi(v.w) * rs);
            *yp = p;
        }
    }
}

__device__ __forceinline__ void fox_cum_phase(const Args& a, LAS unsigned char* lds, int bid, int G, int tid, int wid, int lane) {
    unsigned char* ws = a.ws; asm volatile("" : "+s"(ws));
    const float* LF = (const float*)(ws + WS_LF); float* CUM = (float*)(ws + WS_CUM);
    LAS float* wt = (LAS float*)lds;
    for (int sq = bid; sq < 32; sq += G) {
        __syncthreads();
        const float* src = LF + (size_t)sq * SEQ + tid * 16;
        f32x4 v[4]; float run = 0.f;
#pragma unroll
        for (int k = 0; k < 4; ++k) { v[k] = *(const f32x4*)(src + 4 * k);
#pragma unroll
            for (int q = 0; q < 4; ++q) { run += v[k][q]; v[k][q] = run; } }
        float tot = run;
#pragma unroll
        for (int o = 1; o < 64; o <<= 1) { const float t = __shfl_up(tot, o); if (lane >= o) tot += t; }
        if (lane == 63) wt[wid] = tot;
        __syncthreads();
        float base = tot - run;
        for (int w = 0; w < wid; ++w) base += wt[w];
        float* dst = CUM + (size_t)sq * SEQ + tid * 16;
#pragma unroll
        for (int k = 0; k < 4; ++k) *(f32x4*)(dst + 4 * k) = (v[k] + base) * LOG2E;
    }
}
__device__ __forceinline__ void moba_kmean_phase(const Args& a, int bid, int G, int tid) {
    unsigned char* ws = a.ws; asm volatile("" : "+s"(ws));
    const bf16* K = (const bf16*)(ws + WS_K); float* KM = (float*)(ws + WS_KM);
    for (int u = bid; u < 64; u += G) {
        const int b = u >> 5, j = u & 31;
        const unsigned* src = (const unsigned*)(K + (size_t)(b * SEQ + j * 256) * DM) + tid;
        float s0 = 0.f, s1 = 0.f;
#pragma unroll 8
        for (int r = 0; r < 256; ++r) { const unsigned v = src[(size_t)r * 512]; s0 += bflo(v); s1 += bfhi(v); }
        const int col = 2 * tid, h = col >> 6, d = col & 63;
        float* dst = KM + ((size_t)((b * 16 + h) * 32 + j)) * 64 + d;
        dst[0] = s0 * (1.f / 256.f); dst[1] = s1 * (1.f / 256.f);
    }
}

template <bool FOX>
__device__ __forceinline__ void attn_phase(const Args& a, LAS unsigned char* lds, int bid, int G, int tid, int wid, int lane) {
    unsigned char* ws = a.ws; asm volatile("" : "+s"(ws));
    const bf16* Q = (const bf16*)(ws + WS_Q); const bf16* K = (const bf16*)(ws + WS_K); const bf16* VT = (const bf16*)(ws + WS_VT);
    const float* CUM = (const float*)(ws + WS_CUM); const float* KM = (const float*)(ws + WS_KM); bf16* O = (bf16*)(ws + WS_O);
    constexpr int L_K = 0, L_V = 18432, L_CK = 36864, L_KM = 37376, L_UM = 45568, L_BL = 45584;
    const int r32 = lane & 31, hi = lane >> 5;
    const float NEG = -INFINITY;
    for (int ui = 0; ui < 4; ++ui) {
        const int v = bid + 0 * G;
        const int bh = v >> 3, sx = v & 7;
        const int qb = (ui == 0) ? sx : (ui == 1) ? 15 - sx : (ui == 2) ? 16 + sx : 31 - sx;
        const int b = bh >> 4, h = bh & 15;
        const int q0 = qb * 256, qw = q0 + wid * 32, q = qw + r32;
        __syncthreads();
        bf16x8 qf[4];
#pragma unroll
        for (int d0 = 0; d0 < 4; ++d0) qf[d0] = *(const bf16x8*)(Q + (size_t)(b * SEQ + q) * DM + h * 64 + 16 * d0 + 8 * hi);
        unsigned selmask = 0xffffffffu;
        if (!FOX) {
            *(LAS f32x4*)(lds + L_KM + tid * 16) = *(const f32x4*)(KM + (size_t)bh * 2048 + tid * 4);
            if (tid == 0) *(LAS unsigned*)(lds + L_UM) = 0u;
            __syncthreads();
            float qv[32];
#pragma unroll
            for (int d0 = 0; d0 < 4; ++d0) { const u32x4 t = __builtin_bit_cast(u32x4, qf[d0]);
                qv[d0 * 8 + 0] = bflo(t.x); qv[d0 * 8 + 1] = bfhi(t.x); qv[d0 * 8 + 2] = bflo(t.y); qv[d0 * 8 + 3] = bfhi(t.y);
                qv[d0 * 8 + 4] = bflo(t.z); qv[d0 * 8 + 5] = bfhi(t.z); qv[d0 * 8 + 6] = bflo(t.w); qv[d0 * 8 + 7] = bfhi(t.w); }
            float v1 = NEG, v2 = NEG, v3 = NEG; int i1 = -1, i2 = -1, i3 = -1;
            for (int j = 0; j < qb; ++j) {
                float part = 0.f;
#pragma unroll
                for (int d0 = 0; d0 < 4; ++d0) {
                    const f32x4 k0 = *(LAS f32x4*)(lds + L_KM + (j * 64 + 16 * d0 + 8 * hi) * 4), k1 = *(LAS f32x4*)(lds + L_KM + (j * 64 + 16 * d0 + 8 * hi + 4) * 4);
                    part += qv[d0 * 8 + 0] * k0[0] + qv[d0 * 8 + 1] * k0[1] + qv[d0 * 8 + 2] * k0[2] + qv[d0 * 8 + 3] * k0[3]
                          + qv[d0 * 8 + 4] * k1[0] + qv[d0 * 8 + 5] * k1[1] + qv[d0 * 8 + 6] * k1[2] + qv[d0 * 8 + 7] * k1[3];
                }
                const float gsc = part + __shfl_xor(part, 32);
                if (gsc > v1) { v3 = v2; i3 = i2; v2 = v1; i2 = i1; v1 = gsc; i1 = j; }
                else if (gsc > v2) { v3 = v2; i3 = i2; v2 = gsc; i2 = j; }
                else if (gsc > v3) { v3 = gsc; i3 = j; }
            }
            selmask = (i1 >= 0 ? (1u << i1) : 0u) | (i2 >= 0 ? (1u << i2) : 0u) | (i3 >= 0 ? (1u << i3) : 0u);
            __hip_atomic_fetch_or((LAS unsigned*)(lds + L_UM), selmask, __ATOMIC_RELAXED, __HIP_MEMORY_SCOPE_WORKGROUP);
            __syncthreads();
        }
        if (tid == 0) {
            unsigned um = FOX ? ((qb == 0) ? 0u : (0xffffffffu >> (32 - qb))) : *(LAS unsigned*)(lds + L_UM);
            um |= (1u << qb);
            int n = 0;
            for (int j = 0; j <= qb; ++j) if ((um >> j) & 1u) { *(LAS int*)(lds + L_BL + 4 + 4 * n) = j; ++n; }
            *(LAS int*)(lds + L_BL) = n;
        }
        __syncthreads();
        const int NTT = 4 * *(LAS int*)(lds + L_BL);
        float cq = 0.f;
        if (FOX) cq = CUM[(size_t)bh * SEQ + q];
        float m = NEG, lsum = 0.f;
        f32x16 o[2]; o[0] = f32x16{}; o[1] = f32x16{};
        const int srow = tid >> 3, spc = tid & 7;
        const bf16* kg = K + (size_t)(b * SEQ + srow) * DM + h * 64 + spc * 8;
        const bf16* vg = VT + (size_t)(bh * 64 + srow) * SEQ + spc * 8;
        const float* cg_ = CUM + (size_t)bh * SEQ + (tid & 63);
        u32x4 kreg, vreg; float creg = 0.f;
        {
            const int blk = *(LAS int*)(lds + L_BL + 4); const int k0 = blk * 256;
            kreg = *(const u32x4*)(kg + (size_t)k0 * DM); vreg = *(const u32x4*)(vg + k0);
            if (FOX && tid < 64) creg = cg_[k0];
            *(LAS u32x4*)(lds + L_K + srow * 144 + spc * 16) = kreg; *(LAS u32x4*)(lds + L_V + srow * 144 + spc * 16) = vreg;
            if (FOX && tid < 64) *(LAS float*)(lds + L_CK + tid * 4) = creg;
        }
        __syncthreads();
        for (int ti = 0; ti < NTT; ++ti) {
            const int cur = ti & 1;
            const int blk = *(LAS int*)(lds + L_BL + 4 + 4 * (ti >> 2)); const int k0 = blk * 256 + (ti & 3) * 64;
            const bool more = ti + 1 < NTT;
            if (more) {
                const int nblk = *(LAS int*)(lds + L_BL + 4 + 4 * ((ti + 1) >> 2)); const int nk0 = nblk * 256 + ((ti + 1) & 3) * 64;
                kreg = *(const u32x4*)(kg + (size_t)nk0 * DM); vreg = *(const u32x4*)(vg + nk0);
                if (FOX && tid < 64) creg = cg_[nk0];
            }
            const bool isown = (blk == qb);
            bool active;
            if (isown) active = (k0 <= qw + 31);
            else active = FOX ? true : (__ballot((selmask >> blk) & 1u) != 0ull);
            if (active) {
                const LAS unsigned char* kb = lds + L_K + cur * 9216; const LAS unsigned char* vb = lds + L_V + cur * 9216;
                f32x16 s0 = f32x16{}, s1 = f32x16{};
#pragma unroll
                for (int d0 = 0; d0 < 4; ++d0) {
                    const bf16x8 kf0 = *(const LAS bf16x8*)(kb + r32 * 144 + (16 * d0 + 8 * hi) * 2);
                    const bf16x8 kf1 = *(const LAS bf16x8*)(kb + (32 + r32) * 144 + (16 * d0 + 8 * hi) * 2);
                    s0 = __builtin_amdgcn_mfma_f32_32x32x16_bf16(kf0, qf[d0], s0, 0, 0, 0);
                    s1 = __builtin_amdgcn_mfma_f32_32x32x16_bf16(kf1, qf[d0], s1, 0, 0, 0);
                }
                if (FOX) {
                    const LAS unsigned char* cb = lds + L_CK + cur * 256;
#pragma unroll
                    for (int i = 0; i < 4; ++i) {
                        const f32x4 c0 = *(const LAS f32x4*)(cb + (8 * i + 4 * hi) * 4), c1 = *(const LAS f32x4*)(cb + (32 + 8 * i + 4 * hi) * 4);
#pragma unroll
                        for (int t = 0; t < 4; ++t) { s0[4 * i + t] += cq - c0[t]; s1[4 * i + t] += cq - c1[t]; }
                    }
                }
                if (isown) {
#pragma unroll
                    for (int r = 0; r < 16; ++r) { const int key = k0 + crow(r, hi); if (key > q) s0[r] = NEG; if (key + 32 > q) s1[r] = NEG; }
                } else if (!FOX) {
                    if (!((selmask >> blk) & 1u)) {
#pragma unroll
                        for (int r = 0; r < 16; ++r) { s0[r] = NEG; s1[r] = NEG; }
                    }
                }
                float mx = fmaxf(s0[0], s1[0]);
#pragma unroll
                for (int r = 1; r < 16; ++r) mx = fmaxf(mx, fmaxf(s0[r], s1[r]));
                mx = fmaxf(mx, __shfl_xor(mx, 32));
                const float mnew = fmaxf(m, mx);
                const float msafe = (mnew == NEG) ? 0.f : mnew;
                const float f = __builtin_amdgcn_exp2f(m - msafe);
                m = mnew;
                float ps = 0.f;
#pragma unroll
                for (int r = 0; r < 16; ++r) { s0[r] = __builtin_amdgcn_exp2f(s0[r] - msafe); s1[r] = __builtin_amdgcn_exp2f(s1[r] - msafe); ps += s0[r] + s1[r]; }
                lsum = lsum * f + ps;
#pragma unroll
                for (int r = 0; r < 16; ++r) { o[0][r] *= f; o[1][r] *= f; }
#pragma unroll
                for (int kt = 0; kt < 2; ++kt)
#pragma unroll
                    for (int ks = 0; ks < 2; ++ks) {
                        u32x4 pw;
                        if (kt == 0) { pw.x = pk2(s0[8 * ks], s0[8 * ks + 1]); pw.y = pk2(s0[8 * ks + 2], s0[8 * ks + 3]); pw.z = pk2(s0[8 * ks + 4], s0[8 * ks + 5]); pw.w = pk2(s0[8 * ks + 6], s0[8 * ks + 7]); }
                        else { pw.x = pk2(s1[8 * ks], s1[8 * ks + 1]); pw.y = pk2(s1[8 * ks + 2], s1[8 * ks + 3]); pw.z = pk2(s1[8 * ks + 4], s1[8 * ks + 5]); pw.w = pk2(s1[8 * ks + 6], s1[8 * ks + 7]); }
                        const bf16x8 pf = __builtin_bit_cast(bf16x8, pw);
#pragma unroll
                        for (int d0 = 0; d0 < 2; ++d0) {
                            const LAS unsigned char* vp = vb + (32 * d0 + r32) * 144 + (32 * kt + 16 * ks + 4 * hi) * 2;
                            const u32x2 xa = *(const LAS u32x2*)vp, xb = *(const LAS u32x2*)(vp + 16);
                            const bf16x8 vf = __builtin_bit_cast(bf16x8, (u32x4){xa.x, xa.y, xb.x, xb.y});
                            o[d0] = __builtin_amdgcn_mfma_f32_32x32x16_bf16(vf, pf, o[d0], 0, 0, 0);
                        }
                    }
            }
            if (more) {
                const int nb = cur ^ 1;
                *(LAS u32x4*)(lds + L_K + nb * 9216 + srow * 144 + spc * 16) = kreg; *(LAS u32x4*)(lds + L_V + nb * 9216 + srow * 144 + spc * 16) = vreg;
                if (FOX && tid < 64) *(LAS float*)(lds + L_CK + nb * 256 + tid * 4) = creg;
            }
            __syncthreads();
        }
        lsum += __shfl_xor(lsum, 32);
        const float inv = 1.f / lsum;
        bf16* op = O + (size_t)(b * SEQ + q) * DM + h * 64;
#pragma unroll
        for (int d0 = 0; d0 < 2; ++d0)
#pragma unroll
            for (int i = 0; i < 4; ++i) {
                u32x2 p; p.x = pk2(o[d0][4 * i] * inv, o[d0][4 * i + 1] * inv); p.y = pk2(o[d0][4 * i + 2] * inv, o[d0][4 * i + 3] * inv);
                *(u32x2*)(op + 32 * d0 + 8 * i + 4 * hi) = p;
            }
    }
}

#define XB_TMO      128
#define XB_XCNT(j)  (256  + 64 * (j))
#define XB_XSUB(j)  (1280 + 64 * (j))
#define XB_XGEN(j)  (2304 + 64 * (j))
#define XB_TOP      3328
#define XB_TOPGEN   3392
#define XCD_BAR_WORDS 3456
#define XB_SPIN_CAP (1u << 18)

__device__ __forceinline__ unsigned xb_ld(unsigned* p)              { return __hip_atomic_load(p, __ATOMIC_RELAXED, __HIP_MEMORY_SCOPE_AGENT); }
__device__ __forceinline__ unsigned xb_add(unsigned* p, unsigned v) { return __hip_atomic_fetch_add(p, v, __ATOMIC_RELAXED, __HIP_MEMORY_SCOPE_AGENT); }
__device__ __forceinline__ unsigned xb_xcc_id() { return (unsigned)__builtin_amdgcn_s_getreg((3 << 11) | 20) & 0xFu; }
#define XB_SPIN(cond, bar) do { unsigned _sp = 0; while (cond) { __builtin_amdgcn_s_sleep(1); \
    if ((++_sp & 255u) == 0u) { if (xb_ld(&(bar)[XB_TMO])) break; if (_sp > XB_SPIN_CAP) { atomicAdd(&(bar)[XB_TMO], 1u); break; } } } } while (0)

struct XcdBarrier {
    unsigned* bar; unsigned x;
    volatile LAS unsigned* st;
};

__device__ __forceinline__ XcdBarrier xcd_barrier_post(unsigned* bar, volatile LAS unsigned* st) {
    XcdBarrier b; b.bar = bar; b.x = xb_xcc_id(); b.st = st;
    if (threadIdx.x == 0) (void)xb_add(&bar[XB_XCNT(b.x)], 1u);
    return b;
}
__device__ __forceinline__ void xcd_barrier_complete(unsigned* bar, unsigned x, unsigned& nloc, unsigned& nx) {
    const unsigned G = gridDim.x * gridDim.y * gridDim.z;
    unsigned sum, cnt, mine, sp = 0u;
    for (;;) {
        sum = 0u; cnt = 0u; mine = 0u;
#pragma unroll
        for (unsigned j = 0; j < 16; ++j) { const unsigned c = xb_ld(&bar[XB_XCNT(j)]); sum += c; cnt += (c > 0u) ? 1u : 0u; mine = (j == x) ? c : mine; }
        if (sum == G) break;
        __builtin_amdgcn_s_sleep(1);
        if ((++sp & 255u) == 0u) { if (xb_ld(&bar[XB_TMO])) break; if (sp > XB_SPIN_CAP) { atomicAdd(&bar[XB_TMO], 1u); break; } }
    }
    nloc = mine > 0u ? mine : 1u; nx = cnt > 0u ? cnt : 1u;
}

__device__ __forceinline__ void xcd_barrier(const XcdBarrier& b) {
    asm volatile("s_waitcnt vmcnt(0)" ::: "memory");
    __syncthreads();
    if (threadIdx.x == 0) {
        unsigned* bar = b.bar;
        __builtin_amdgcn_s_waitcnt(0);
        unsigned nloc = b.st[0], nx = b.st[1];
        if (nloc == 0u) { xcd_barrier_complete(bar, b.x, nloc, nx); b.st[0] = nloc; b.st[1] = nx; }
        const unsigned old = xb_add(&bar[XB_XSUB(b.x)], 1u);
        const unsigned gen = old / nloc;
        if (old + 1u == (gen + 1u) * nloc) {
            __builtin_amdgcn_fence(__ATOMIC_RELEASE, "agent");
            asm volatile("s_waitcnt vmcnt(0)" ::: "memory");
            const unsigned og = xb_add(&bar[XB_TOP], 1u);
            const unsigned tg = og / nx;
            if (og + 1u == (tg + 1u) * nx) xb_add(&bar[XB_TOPGEN], 1u);
            else XB_SPIN(xb_ld(&bar[XB_TOPGEN]) == tg, bar);
            __builtin_amdgcn_fence(__ATOMIC_ACQUIRE, "agent");
            xb_add(&bar[XB_XGEN(b.x)], 1u);
            asm volatile("s_waitcnt vmcnt(0)" ::: "memory");
        } else {
            XB_SPIN(xb_ld(&bar[XB_XGEN(b.x)]) == gen, bar);
            __builtin_amdgcn_fence(__ATOMIC_ACQUIRE, "agent");
            asm volatile("s_waitcnt vmcnt(0)" ::: "memory");
        }
    }
    __syncthreads();
}
enum { OP_INIT = 0, OP_FFN_UP, OP_FFN_DOWN, OP_LN, OP_SSM_IN, OP_CONV, OP_DIAG, OP_SCAN, OP_YOFF, OP_MIX_OUT, OP_ATT_IN, OP_AUX, OP_ATTN };
#ifdef PROBE_PH
constexpr int N_PHASES = 50;
#else
constexpr int N_PHASES = 49;
#endif

__global__ void __launch_bounds__(512, 2) fwd_mega(Args a_) {
    extern __shared__ __attribute__((aligned(16))) unsigned char smem[];
    LAS unsigned char* lds = (LAS unsigned char*)smem;
    cg::grid_group grid = cg::this_grid();
    const int tid0 = threadIdx.x;
    const int G0 = gridDim.x, bid0 = blockIdx.x;
    const int ph_lo = a_.ph_lo, ph_hi = a_.ph_hi;
    if (tid0 < 2) *(LAS unsigned*)(lds + L_XBST + 4 * tid0) = 0u;
    __syncthreads();
    XcdBarrier xbar; xbar.bar = (unsigned*)(a_.ws + WS_CTL); xbar.x = 0; xbar.st = nullptr;
    if (ph_hi - ph_lo > 1) xbar = xcd_barrier_post((unsigned*)(a_.ws + WS_CTL), (volatile LAS unsigned*)(lds + L_XBST));
    for (int ph = ph_lo; ph < ph_hi; ++ph) {
        int L = 0, op = OP_INIT, sub = 0;
        int phx = ph;
#ifdef PROBE_PH
        if (ph > PROBE_PH) phx = ph - 1;
#endif
        if (phx > 0) {
            int p = phx - 1;
            if (p >= 35) { L = 3; p -= 35; } else if (p >= 24) { L = 2; p -= 24; } else if (p >= 13) { L = 1; p -= 13; } else L = 0;
            const bool ssm = (L % 3) == 0;
            const int nmix = ssm ? 7 : 5;
            if (p < 3) { op = p == 0 ? OP_FFN_UP : p == 1 ? OP_FFN_DOWN : OP_LN; sub = 0; }
            else if (p < 3 + nmix) {
                const int q = p - 3;
                if (ssm) { op = q == 0 ? OP_SSM_IN : q == 1 ? OP_CONV : q == 2 ? OP_DIAG : q == 3 ? OP_SCAN : q == 4 ? OP_YOFF : q == 5 ? OP_MIX_OUT : OP_LN; }
                else { op = q == 0 ? OP_ATT_IN : q == 1 ? OP_AUX : q == 2 ? OP_ATTN : q == 3 ? OP_MIX_OUT : OP_LN; }
                sub = 1;
            } else { const int q = p - 3 - nmix; op = q == 0 ? OP_FFN_UP : q == 1 ? OP_FFN_DOWN : OP_LN; sub = (op == OP_LN) ? 2 : 1; }
        }
        const int kind = L % 3, jj = L / 3;
        {
        const __attribute__((address_space(4))) Args* ap = (const __attribute__((address_space(4))) Args*)__builtin_amdgcn_kernarg_segment_ptr();
        asm volatile("" : "+s"(ap));
#if defined(__HIP_DEVICE_COMPILE__)
        const Args a = *ap;
#else
        const Args a = a_;
#endif
        int tid = tid0, G = G0, bid = bid0; unsigned char* ws = a.ws;
        asm volatile("" : "+v"(tid)); asm volatile("" : "+s"(G), "+s"(bid), "+s"(ws));
        const int lane = tid & 63, wid = __builtin_amdgcn_readfirstlane(tid >> 6);
        const int gw = bid * 8 + wid, NGW = G * 8;
        const bool is_gemm = (op == OP_FFN_UP || op == OP_FFN_DOWN || op == OP_SSM_IN || op == OP_MIX_OUT || op == OP_ATT_IN);
        if (is_gemm) {
            pg8::Gemm g; Epi E; E.mode = 0; E.w = 1.f; E.out = a.out; E.ws = ws; E.bias = nullptr;
            g.M = MTOK; int kc = 0;
            if (op == OP_FFN_UP) { g.A = (const bf16*)(ws + WS_H16); g.Bt = (const bf16*)(ws + (sub ? WS_WGU1 : WS_WGU0)); g.N = 5632; E.mode = 0; }
            else if (op == OP_FFN_DOWN) { g.A = (const bf16*)(ws + WS_ACT); g.Bt = (const bf16*)(ws + (sub ? WS_WD1 : WS_WD0)); g.N = DM; kc = 1; E.mode = 1; E.w = 0.5f; }
            else if (op == OP_SSM_IN) { g.A = (const bf16*)(ws + WS_H16); g.Bt = (const bf16*)(ws + WS_WIN); g.N = 5376; E.mode = 2; E.bias = a.ssm_dtb + jj * 32; }
            else if (op == OP_ATT_IN) { g.A = (const bf16*)(ws + WS_H16); g.Bt = (const bf16*)(ws + WS_WIN); g.N = kind == 1 ? 3328 : 3072; E.mode = 3; E.bias = a.fox_bf + jj * 16; }
            else { g.Bt = (const bf16*)(ws + WS_WOUT); g.N = DM; E.mode = 1; E.w = 1.f;
                   if (kind == 0) { g.A = (const bf16*)(ws + WS_Y); kc = 2; } else { g.A = (const bf16*)(ws + WS_O); } }
            pg8::StaticOrder S; S.init(g.M, g.N, G, bid);
            if (kc == 0) { g.K = DM; pg8::gemm_phase<Epi, pg8::StaticOrder, true, true>(lds, g, S, E); }
            else { EpiRes E1; E1.w = E.w; E1.out = a.out; if (kc == 1) { g.K = DFF; pg8::gemm_phase<EpiRes, pg8::StaticOrder, true, true>(lds, g, S, E1); } else { g.K = 2048; pg8::gemm_phase<EpiRes, pg8::StaticOrder, true, true>(lds, g, S, E1); } }
        } else if (op == OP_INIT) {
            convert_layer(a, 0, lds, gw, NGW, wid, lane);
            const f32x4* xs = (const f32x4*)a.x; f32x4* od = (f32x4*)a.out; u32x2* hd = (u32x2*)(ws + WS_H16);
            for (int i = bid * 512 + tid; i < MTOK * DM / 4; i += G * 512) { const f32x4 v = xs[i]; od[i] = v; u32x2 p; p.x = pk2(v[0], v[1]); p.y = pk2(v[2], v[3]); hd[i] = p; }
        } else if (op == OP_LN) {
            ln_pass(a.out, (bf16*)(ws + WS_H16), a.lng + (size_t)(L * 3 + sub) * DM, a.lnb + (size_t)(L * 3 + sub) * DM, gw, NGW, lane);
            if (sub == 2 && L < 3) convert_layer(a, L + 1, lds, gw, NGW, wid, lane);
        } else if (op == OP_CONV) { conv_phase(a, jj, lds, bid, G, tid, wid, lane);
        } else if (op == OP_DIAG) { ssd_diag_phase(a, jj, lds, bid, G, tid, wid, lane);
        } else if (op == OP_SCAN) { ssd_scan_phase(a, bid, G, tid);
        } else if (op == OP_YOFF) { ssd_out_phase(a, lds, bid, G, tid, wid, lane);
        } else if (op == OP_AUX) { if (kind == 1) fox_cum_phase(a, lds, bid, G, tid, wid, lane); else moba_kmean_phase(a, bid, G, tid);
        } else if (op == OP_ATTN) { if (kind == 1) attn_phase<true>(a, lds, bid, G, tid, wid, lane); else attn_phase<false>(a, lds, bid, G, tid, wid, lane); }
        }
        if (ph + 1 < ph_hi) { if (ph == ph_lo) grid.sync(); else xcd_barrier(xbar); }
    }
}

extern "C" void kernel_launch(void* const* d_in, const int* in_sizes, int n_in, void* d_out, int out_size, void* d_ws, size_t ws_size, hipStream_t stream) {
    static int grid = 0;
    if (grid == 0) {
        if (n_in != 19 || out_size != MTOK * DM || ws_size < WS_END) { fprintf(stderr, "kernel_launch: unexpected shapes (n_in %d out %d ws %zu)\n", n_in, out_size, ws_size); grid = -1; return; }
        int dev = 0, cus = 0, per_cu = 0;
        hipGetDevice(&dev); hipDeviceGetAttribute(&cus, hipDeviceAttributeMultiprocessorCount, dev);
        if (hipFuncSetAttribute((const void*)fwd_mega, hipFuncAttributeMaxDynamicSharedMemorySize, LDS_BYTES) != hipSuccess) { fprintf(stderr, "kernel_launch: hipFuncSetAttribute failed\n"); grid = -1; return; }
        hipOccupancyMaxActiveBlocksPerMultiprocessor(&per_cu, (const void*)fwd_mega, 512, LDS_BYTES);
        (void)hipGetLastError();
        if (cus != 256 || per_cu < 1) fprintf(stderr, "kernel_launch: note: cus %d per_cu %d (built for 256 x 1)\n", cus, per_cu);
        grid = 256;
    }
    if (grid < 0) return;
    Args a{};
    a.x = (const float*)d_in[0]; a.wg = (const float*)d_in[1]; a.wu = (const float*)d_in[2]; a.wd = (const float*)d_in[3]; a.lng = (const float*)d_in[4]; a.lnb = (const float*)d_in[5];
    a.ssm_win = (const float*)d_in[6]; a.ssm_cw = (const float*)d_in[7]; a.ssm_cb = (const float*)d_in[8]; a.ssm_dtb = (const float*)d_in[9]; a.ssm_alog = (const float*)d_in[10];
    a.ssm_d = (const float*)d_in[11]; a.ssm_nw = (const float*)d_in[12]; a.ssm_wout = (const float*)d_in[13]; a.fox_win = (const float*)d_in[14]; a.fox_bf = (const float*)d_in[15];
    a.fox_wout = (const float*)d_in[16]; a.moba_win = (const float*)d_in[17]; a.moba_wout = (const float*)d_in[18];
    a.out = (float*)d_out; a.ws = (unsigned char*)d_ws;
    if (hipMemsetAsync((char*)d_ws + WS_CTL, 0, CTL_BYTES, stream) != hipSuccess) { fprintf(stderr, "kernel_launch: memset failed\n"); return; }
#if MK_MULTI
    for (int ph = 0; ph < N_PHASES; ++ph) { a.ph_lo = ph; a.ph_hi = ph + 1; hipLaunchKernelGGL(fwd_mega, dim3(grid), dim3(512), LDS_BYTES, stream, a); }
#else
    a.ph_lo = 0; a.ph_hi = N_PHASES;
    void* args[] = {&a};
    hipError_t e = hipLaunchCooperativeKernel((const void*)fwd_mega, dim3(grid), dim3(512), args, LDS_BYTES, stream);
    if (e != hipSuccess) fprintf(stderr, "cooperative launch failed: %s\n", hipGetErrorString(e));
#endif
}
```
